# Optimizing an MI355X kernel written in HIP

```python
import jax, jax.numpy as jnp
from jax import lax
import numpy as np

D_MODEL = 1024
BATCH = 8
SEQ = 8192
DEPTH = 4

CHUNK = 64
N_EVEN = (DEPTH + 1) // 2
N_ODD = DEPTH // 2
D_FF = 4 * D_MODEL
RMS_EPS = 1e-6
RET_WIDTH = D_MODEL // 2
RET_HEADS = 4
RET_HEAD_DIM = RET_WIDTH // RET_HEADS
RET_ROPE_BASE = 10000.0
GN_EPS = 1e-5
POOL_WIDTH = D_MODEL - RET_WIDTH
POOL_WINDOWS = (2, 4, 8, 16)
POOL_GROUPS = len(POOL_WINDOWS)
POOL_GROUP_DIM = POOL_WIDTH // POOL_GROUPS
AB_IN_WIDTH = 4 * RET_WIDTH + POOL_WIDTH
AB_OUT_WIDTH = RET_WIDTH + POOL_WIDTH
ATT_HEADS = 16
ATT_HEAD_DIM = D_MODEL // ATT_HEADS
LEFT_CHUNKS = 8
BAND = (LEFT_CHUNKS + 1) * CHUNK
REL_CLIP = 128
N_REL = 2 * REL_CLIP + 1
NEG_INF = -1e30

kernel_name = "hybrid_retention_pool_chunkattn_trunk"


def rms_norm(x, g):
    xf = x.astype(jnp.float32)
    y = xf * lax.rsqrt(jnp.mean(xf * xf, axis=-1, keepdims=True) + RMS_EPS)
    return (y * g.astype(jnp.float32)).astype(x.dtype)


def rotary(x):
    S, d = x.shape[1], x.shape[-1]
    inv_freq = 1.0 / (RET_ROPE_BASE ** jnp.linspace(0.0, 1.0, d // 2, dtype=jnp.float32))
    ang = jnp.arange(S, dtype=jnp.float32)[:, None] * inv_freq[None, :]
    cos = jnp.cos(ang)[None, :, None, :]
    sin = jnp.sin(ang)[None, :, None, :]
    x1, x2 = x[..., 0::2], x[..., 1::2]
    return jnp.stack([x1 * cos - x2 * sin, x1 * sin + x2 * cos], axis=-1).reshape(x.shape)


def retention(q, k, v):
    B, S, H, d = q.shape
    nc = S // CHUNK
    log_g = jnp.log1p(-jnp.power(2.0, -5.0 - jnp.arange(H, dtype=jnp.float32)))
    pos = jnp.arange(CHUNK, dtype=jnp.float32)
    intra_decay = jnp.exp(jnp.abs(pos[:, None] - pos[None, :])[None] * log_g[:, None, None])
    q_decay = jnp.exp((pos[:, None] + 1.0) * log_g[None, :])
    k_decay = jnp.exp((CHUNK - 1.0 - pos[:, None]) * log_g[None, :])
    chunk_decay = jnp.exp(CHUNK * log_g)

    qc = q.reshape(B, nc, CHUNK, H, d)
    kc = k.reshape(B, nc, CHUNK, H, d)
    vc = v.reshape(B, nc, CHUNK, H, d)
    scores = jnp.einsum('bcnhd,bcmhd->bchnm', qc, kc) * intra_decay
    intra = jnp.einsum('bchnm,bcmhe->bcnhe', scores, vc)

    def step(state, inp):
        q_i, k_i, v_i = inp
        cross = jnp.einsum('bnhd,bhde->bnhe', q_i * q_decay[:, :, None], state)
        state = state * chunk_decay[:, None, None] + jnp.einsum(
            'bmhd,bmhe->bhde', k_i * k_decay[:, :, None], v_i)
        return state, cross

    xs = (jnp.moveaxis(qc, 1, 0), jnp.moveaxis(kc, 1, 0), jnp.moveaxis(vc, 1, 0))
    state0 = jnp.zeros((B, H, d, d), jnp.float32)
    _, cross = lax.scan(step, state0, xs)
    out = intra + jnp.moveaxis(cross, 0, 1)
    return out.reshape(B, S, H, d)


def head_group_norm(o, g):
    B, S, H, d = o.shape
    mu = jnp.mean(o, axis=-1, keepdims=True)
    var = jnp.mean(jnp.square(o - mu), axis=-1, keepdims=True)
    y = (o - mu) * lax.rsqrt(var + GN_EPS)
    return y.reshape(B, S, H * d) * g


def multiscale_pool(p, w_group, scale):
    B, S, _ = p.shape
    pf = p.astype(jnp.float32).reshape(B, S, POOL_GROUPS, POOL_GROUP_DIM)
    csum = lax.cumsum(pf, axis=1)
    t = jnp.arange(S)
    outs = []
    for gi, w in enumerate(POOL_WINDOWS):
        c = csum[:, :, gi]
        lagged = jnp.pad(c, ((0, 0), (w, 0), (0, 0)))[:, :S]
        count = jnp.minimum(t + 1, w).astype(jnp.float32)[None, :, None]
        outs.append((c - lagged) / count - pf[:, :, gi])
    pooled = jnp.stack(outs, axis=2)
    mixed = jnp.einsum('bsgc,gce->bsge', pooled, w_group.astype(jnp.float32))
    return (mixed.reshape(B, S, POOL_WIDTH) * scale.astype(jnp.float32)).astype(p.dtype)


def retention_pool_mixer(h, w_in, gn_gain, w_pool, pool_scale, w_out):
    B, S, _ = h.shape
    z = h @ w_in
    q, k, v, g, p = jnp.split(
        z, [RET_WIDTH, 2 * RET_WIDTH, 3 * RET_WIDTH, 4 * RET_WIDTH], axis=-1)

    def heads(t):
        return t.astype(jnp.float32).reshape(B, S, RET_HEADS, RET_HEAD_DIM)

    qh = rotary(heads(q))
    kh = rotary(heads(k)) * (RET_HEAD_DIM ** -0.5)
    o = retention(qh, kh, heads(v))
    o = head_group_norm(o, gn_gain.astype(jnp.float32))
    ret_out = (jax.nn.silu(g.astype(jnp.float32)) * o).astype(h.dtype)
    pool_out = multiscale_pool(p, w_pool, pool_scale)
    return jnp.concatenate([ret_out, pool_out], axis=-1) @ w_out


def chunk_attention(h, w_qkv, rel_bias, w_out):
    B, S, _ = h.shape
    nc = S // CHUNK
    q, k, v = jnp.split(h @ w_qkv, 3, axis=-1)
    q = q.reshape(B, S, ATT_HEADS, ATT_HEAD_DIM) * (ATT_HEAD_DIM ** -0.5)
    pad = ((0, 0), (LEFT_CHUNKS * CHUNK, 0), (0, 0), (0, 0))
    k = jnp.pad(k.reshape(B, S, ATT_HEADS, ATT_HEAD_DIM), pad)
    v = jnp.pad(v.reshape(B, S, ATT_HEADS, ATT_HEAD_DIM), pad)
    n_idx = jnp.arange(CHUNK)[:, None]
    j_idx = jnp.arange(BAND)[None, :]
    rel = jnp.clip(n_idx + LEFT_CHUNKS * CHUNK - j_idx, -REL_CLIP, REL_CLIP) + REL_CLIP
    bias = rel_bias.astype(jnp.float32)[:, rel]
    band_pos = jnp.arange(BAND)

    def one_chunk(c):
        q_c = lax.dynamic_slice_in_dim(q, c * CHUNK, CHUNK, axis=1)
        k_b = lax.dynamic_slice_in_dim(k, c * CHUNK, BAND, axis=1)
        v_b = lax.dynamic_slice_in_dim(v, c * CHUNK, BAND, axis=1)
        s = jnp.einsum('bnhd,bjhd->bhnj', q_c, k_b).astype(jnp.float32) + bias
        valid = band_pos >= (LEFT_CHUNKS - c) * CHUNK
        s = jnp.where(valid, s, NEG_INF)
        pr = jax.nn.softmax(s, axis=-1).astype(v_b.dtype)
        return jnp.einsum('bhnj,bjhd->bnhd', pr, v_b)

    o = lax.map(one_chunk, jnp.arange(nc))
    o = jnp.moveaxis(o, 0, 1).reshape(B, S, D_MODEL)
    return o @ w_out


def squared_relu_mlp(h, w1, w2):
    return jnp.square(jax.nn.relu(h @ w1)) @ w2


def setup_inputs(seed: int = 0) -> dict:
    key = jax.random.key(seed)
    ks = jax.random.split(key, 16)
    f32 = jnp.float32

    def nrm(k, shape, scale):
        return jax.random.normal(k, shape, f32) * scale

    return {
        "x": nrm(ks[0], (BATCH, SEQ, D_MODEL), 1.0),
        "mix_norm": 1.0 + nrm(ks[1], (DEPTH, D_MODEL), 0.05),
        "ffn_norm": 1.0 + nrm(ks[2], (DEPTH, D_MODEL), 0.05),
        "w_ffn_in": nrm(ks[3], (DEPTH, D_MODEL, D_FF), D_MODEL ** -0.5),
        "w_ffn_out": nrm(ks[4], (DEPTH, D_FF, D_MODEL), D_FF ** -0.5),
        "ab_w_in": nrm(ks[5], (N_EVEN, D_MODEL, AB_IN_WIDTH), D_MODEL ** -0.5),
        "ab_gn_gain": 1.0 + nrm(ks[6], (N_EVEN, RET_WIDTH), 0.05),
        "ab_w_pool": nrm(ks[7], (N_EVEN, POOL_GROUPS, POOL_GROUP_DIM, POOL_GROUP_DIM), POOL_GROUP_DIM ** -0.5),
        "ab_pool_scale": 1.0 + nrm(ks[8], (N_EVEN, POOL_WIDTH), 0.1),
        "ab_w_out": nrm(ks[9], (N_EVEN, AB_OUT_WIDTH, D_MODEL), AB_OUT_WIDTH ** -0.5),
        "c_w_qkv": nrm(ks[10], (N_ODD, D_MODEL, 3 * D_MODEL), D_MODEL ** -0.5),
        "c_rel_bias": nrm(ks[11], (N_ODD, ATT_HEADS, N_REL), 0.5),
        "c_w_out": nrm(ks[12], (N_ODD, D_MODEL, D_MODEL), D_MODEL ** -0.5),
        "final_norm": 1.0 + nrm(ks[13], (D_MODEL,), 0.05),
    }


def reference(x, mix_norm, ffn_norm, w_ffn_in, w_ffn_out, ab_w_in, ab_gn_gain,
              ab_w_pool, ab_pool_scale, ab_w_out, c_w_qkv, c_rel_bias, c_w_out,
              final_norm):
    for layer in range(DEPTH):
        h = rms_norm(x, mix_norm[layer])
        i = layer // 2
        if layer % 2 == 0:
            x = x + retention_pool_mixer(h, ab_w_in[i], ab_gn_gain[i], ab_w_pool[i],
                                         ab_pool_scale[i], ab_w_out[i])
        else:
            x = x + chunk_attention(h, c_w_qkv[i], c_rel_bias[i], c_w_out[i])
        x = x + squared_relu_mlp(rms_norm(x, ffn_norm[layer]), w_ffn_in[layer], w_ffn_out[layer])
    return rms_norm(x, final_norm)
```

```cpp
#include <hip/hip_runtime.h>
#include <hip/hip_cooperative_groups.h>
#include <cstdio>
#include <cstdint>
#include <cmath>
namespace cg = cooperative_groups;
namespace pg8 {
#define PG8_LAS __attribute__((address_space(3)))
typedef unsigned short bf16_t;
typedef short bf16x8 __attribute__((ext_vector_type(8)));
typedef float f32x4 __attribute__((ext_vector_type(4)));
typedef unsigned u32x4 __attribute__((ext_vector_type(4)));
constexpr int BM = 256, BK = 64, HALF = 128, HTB = HALF * BK * 2  , STAGE_BYTES = 8 * HTB, NXCD = 8, WGM = 8;

__host__ __device__ __forceinline__ int lds_byte(int r, int c) { const int st = (r >> 4) * 2 + (c >> 5), rr = r & 15, cc = c & 31, ob = rr * 64 + cc * 2; return st * 1024 + (ob ^ (((ob >> 9) & 1) << 5)); }
__host__ __device__ __forceinline__ void stage_rc(int b, int& R, int& C) { const int st = b / 1024, sb = b % 1024, swz = sb ^ (((sb >> 9) & 1) << 5); R = (st >> 1) * 16 + swz / 64; C = (st & 1) * 32 + (swz % 64) / 2; }
__host__ __device__ __forceinline__ int perm32(int rho) { const int n = rho >> 4, i = rho & 15; return 8 * (i >> 2) + 4 * n + (i & 3); }

struct Unit { int pm, pn; };
struct Gemm { const bf16_t* A; const bf16_t* Bt; int M, N, K; };

struct StaticOrder {
    int nM, nN, nwg, G, c;
    __host__ __device__ void init(int M, int N, int G_, int c_) { nM = M / BM; nN = N / BM; nwg = nM * nN; G = G_; c = c_; }
    __host__ __device__ bool next(int i, Unit& u) const {
        const long L = (long)i * G + c; if (L >= nwg) return false;
        int wgid = (int)L; { const int q = nwg / NXCD, r = nwg % NXCD, xcd = wgid % NXCD, off = wgid / NXCD; wgid = (xcd < r ? xcd * (q + 1) : r * (q + 1) + (xcd - r) * q) + off; }
        const int nig = WGM * nN, gid = wgid / nig, fm = gid * WGM, gsz = (nM - fm) < WGM ? (nM - fm) : WGM;
        u.pm = fm + ((wgid % nig) % gsz); u.pn = (wgid % nig) / gsz; return true;
    }
    __device__ __forceinline__ void a_ready(const Unit&) const {}
    __device__ __forceinline__ void done(const Unit&) const {}
};

template <class Epi, class Sched, bool ALIGN_EPI = false, bool SP2 = false>
__device__ __forceinline__ void gemm_phase(PG8_LAS unsigned char* lds, const Gemm g, const Sched& S, const Epi& E) {
    int tid = threadIdx.x; asm volatile("" : "+v"(tid));
    const int wid = __builtin_amdgcn_readfirstlane(tid >> 6), lane = tid & 63, wr = wid >> 2, wc = wid & 3, fr = lane & 15, fq = lane >> 4;
    const int K = g.K, nt = K / BK;
    unsigned voffA[2], voffB[2];
#pragma unroll
    for (int i = 0; i < 2; ++i) { int R, C; stage_rc(tid * 16 + i * 8192, R, C); const int Rb = Epi::PERM ? ((R & ~31) + perm32(R & 31)) : R;
        voffA[i] = (unsigned)(R * K + C) * 2u; voffB[i] = (unsigned)(Rb * K + C) * 2u; }
    const size_t kstep = (size_t)(BK * 2);
    const size_t hstep = (size_t)HALF * K * 2;
    const size_t tstep = 2 * hstep;
    const unsigned ldsw = (unsigned)wid * 1024u;
    const int aoff = lds_byte(wr * 64 + fr, fq * 8), boff = lds_byte(wc * 32 + fr, fq * 8);
#define PG8_SA(b, h) (((b) * 2 + (h)) * HTB)
#define PG8_SB(b, h) ((4 + (b) * 2 + (h)) * HTB)
#define PG8_STAGE(bufoff, gbase, voff) do { _Pragma("unroll") for (int _i = 0; _i < 2; ++_i) \
        __builtin_amdgcn_global_load_lds((const unsigned*)((const char*)(gbase) + (voff)[_i]), (PG8_LAS unsigned*)(lds + (bufoff) + ldsw + _i * 8192), 16, 0, 0); } while (0)
#define PG8_LDA(dst, b, h) do { _Pragma("unroll") for (int m = 0; m < 4; ++m) _Pragma("unroll") for (int k = 0; k < 2; ++k) dst[m][k] = *(const PG8_LAS bf16x8*)(lds + PG8_SA(b, h) + aoff + m * 2048 + k * 1024); } while (0)
#define PG8_LDB(dst, b, h) do { _Pragma("unroll") for (int n = 0; n < 2; ++n) _Pragma("unroll") for (int k = 0; k < 2; ++k) dst[n][k] = *(const PG8_LAS bf16x8*)(lds + PG8_SB(b, h) + boff + n * 2048 + k * 1024); } while (0)
#define PG8_MMA(ai, bj, At, Bt) do { __builtin_amdgcn_s_setprio(1); _Pragma("unroll") for (int m = 0; m < 4; ++m) _Pragma("unroll") for (int n = 0; n < 2; ++n) _Pragma("unroll") for (int k = 0; k < 2; ++k) \
        acc[ai][bj][m][n] = __builtin_amdgcn_mfma_f32_16x16x32_bf16(Bt[n][k], At[m][k], acc[ai][bj][m][n], 0, 0, 0); __builtin_amdgcn_s_setprio(0); } while (0)
#define PG8_WAIT_V(n) asm volatile("s_waitcnt vmcnt(" #n ")" ::: "memory")
#define PG8_WAIT_L(n) asm volatile("s_waitcnt lgkmcnt(" #n ")" ::: "memory")
#define PG8_BAR __builtin_amdgcn_s_barrier()
#define PG8_SCHED __builtin_amdgcn_sched_barrier(0)
    Unit cur, nxt; int ui = 0;
    if (!S.next(0, cur)) return;
    f32x4 acc[2][2][4][2];
#pragma unroll
    for (int a = 0; a < 2; ++a)
#pragma unroll
        for (int b = 0; b < 2; ++b)
#pragma unroll
            for (int m = 0; m < 4; ++m)
#pragma unroll
                for (int n = 0; n < 2; ++n) acc[a][b][m][n] = (f32x4){0.f, 0.f, 0.f, 0.f};
    bf16x8 At[4][2], B0[2][2], B1[2][2];
    const char* cA = (const char*)g.A + (size_t)cur.pm * tstep; const char* cB = (const char*)g.Bt + (size_t)cur.pn * tstep;
    S.a_ready(cur);
    if constexpr (SP2) {
        PG8_STAGE(PG8_SB(0, 0), cB, voffB); PG8_STAGE(PG8_SB(0, 1), cB + hstep, voffB); PG8_STAGE(PG8_SA(0, 0), cA, voffA); PG8_STAGE(PG8_SA(0, 1), cA + hstep, voffA);
        if (wr == 1) PG8_BAR;
        PG8_WAIT_V(2); PG8_BAR;
        PG8_STAGE(PG8_SB(1, 0), cB + kstep, voffB); PG8_STAGE(PG8_SA(1, 0), cA + kstep, voffA); PG8_STAGE(PG8_SB(1, 1), cB + hstep + kstep, voffB);
        PG8_WAIT_V(6); PG8_BAR;
    } else {
        PG8_STAGE(PG8_SB(0, 0), cB, voffB); PG8_STAGE(PG8_SA(0, 0), cA, voffA); PG8_STAGE(PG8_SB(0, 1), cB + hstep, voffB); PG8_STAGE(PG8_SA(0, 1), cA + hstep, voffA);
        if (wr == 1) PG8_BAR;
        PG8_WAIT_V(4); PG8_BAR;
        PG8_STAGE(PG8_SB(1, 0), cB + kstep, voffB); PG8_STAGE(PG8_SA(1, 0), cA + kstep, voffA); PG8_STAGE(PG8_SB(1, 1), cB + hstep + kstep, voffB);
        PG8_WAIT_V(6); PG8_BAR;
    }
    for (;;) {
        const bool has_next = S.next(ui + 1, nxt);
        const char* nA = has_next ? (const char*)g.A + (size_t)nxt.pm * tstep : cA; const char* nB = has_next ? (const char*)g.Bt + (size_t)nxt.pn * tstep : cB;
        for (int t = 0; t < nt; t += 2) {
            const bool last = (t == nt - 2);
            const char* a1 = cA + (size_t)(t + 1) * kstep;
            const char* a2 = last ? nA : cA + (size_t)(t + 2) * kstep; const char* b2 = last ? nB : cB + (size_t)(t + 2) * kstep;
            const char* a3 = a2 + kstep; const char* b3 = b2 + kstep;
            if (last && has_next) S.a_ready(nxt);
            if constexpr (SP2) {
            PG8_LDB(B0, 0, 0); PG8_LDB(B1, 0, 1); PG8_SCHED; PG8_LDA(At, 0, 0); PG8_STAGE(PG8_SA(1, 1), a1 + hstep, voffA);
            PG8_WAIT_V(8); PG8_WAIT_L(0); PG8_BAR; PG8_MMA(0, 0, At, B0); PG8_MMA(0, 1, At, B1); PG8_BAR; PG8_SCHED;
            PG8_LDA(At, 0, 1); PG8_STAGE(PG8_SB(0, 0), b2, voffB); PG8_STAGE(PG8_SB(0, 1), b2 + hstep, voffB); PG8_STAGE(PG8_SA(0, 0), a2, voffA);
            PG8_WAIT_V(8); PG8_WAIT_L(0); PG8_BAR; PG8_MMA(1, 0, At, B0); PG8_MMA(1, 1, At, B1); PG8_BAR; PG8_SCHED;
            PG8_LDB(B0, 1, 0); PG8_LDB(B1, 1, 1); PG8_SCHED; PG8_LDA(At, 1, 0); PG8_STAGE(PG8_SA(0, 1), a2 + hstep, voffA);
            PG8_WAIT_V(8); PG8_WAIT_L(0); PG8_BAR; PG8_MMA(0, 0, At, B0); PG8_MMA(0, 1, At, B1); PG8_BAR; PG8_SCHED;
            PG8_LDA(At, 1, 1); PG8_STAGE(PG8_SB(1, 0), b3, voffB); PG8_STAGE(PG8_SB(1, 1), b3 + hstep, voffB); PG8_STAGE(PG8_SA(1, 0), a3, voffA);
            PG8_WAIT_V(8); PG8_WAIT_L(0); PG8_BAR; PG8_MMA(1, 0, At, B0); PG8_MMA(1, 1, At, B1); PG8_BAR; PG8_SCHED;
            } else {
            PG8_LDB(B0, 0, 0); PG8_SCHED; PG8_LDA(At, 0, 0); PG8_STAGE(PG8_SA(1, 1), a1 + hstep, voffA);
            PG8_WAIT_L(8); PG8_BAR; PG8_WAIT_L(0); PG8_MMA(0, 0, At, B0); PG8_BAR; PG8_SCHED;
            PG8_LDB(B1, 0, 1); PG8_STAGE(PG8_SB(0, 0), b2, voffB);
            PG8_BAR; PG8_WAIT_L(0); PG8_MMA(0, 1, At, B1); PG8_BAR;
            PG8_LDA(At, 0, 1); PG8_STAGE(PG8_SA(0, 0), a2, voffA);
            PG8_BAR; PG8_WAIT_L(0); PG8_MMA(1, 0, At, B0); PG8_BAR; PG8_SCHED;
            PG8_STAGE(PG8_SB(0, 1), b2 + hstep, voffB);
            PG8_WAIT_V(6); PG8_BAR; PG8_MMA(1, 1, At, B1); PG8_BAR;
            PG8_LDB(B0, 1, 0); PG8_SCHED; PG8_LDA(At, 1, 0); PG8_STAGE(PG8_SA(0, 1), a2 + hstep, voffA);
            PG8_WAIT_L(8); PG8_BAR; PG8_WAIT_L(0); PG8_MMA(0, 0, At, B0); PG8_BAR; PG8_SCHED;
            PG8_LDB(B1, 1, 1); PG8_STAGE(PG8_SB(1, 0), b3, voffB);
            PG8_BAR; PG8_WAIT_L(0); PG8_MMA(0, 1, At, B1); PG8_BAR;
            PG8_LDA(At, 1, 1); PG8_STAGE(PG8_SA(1, 0), a3, voffA);
            PG8_BAR; PG8_WAIT_L(0); PG8_MMA(1, 0, At, B0); PG8_BAR; PG8_SCHED;
            PG8_STAGE(PG8_SB(1, 1), b3 + hstep, voffB);
            PG8_WAIT_V(6); PG8_BAR; PG8_MMA(1, 1, At, B1); PG8_BAR;
            }
        }
        if constexpr (ALIGN_EPI) { if (wr == 0) PG8_BAR; }
        if constexpr (!Epi::AFTER_DRAIN) { E(acc, cur, wr, wc, fr, fq); S.done(cur); }
        if (!has_next) break;
#pragma unroll
        for (int a = 0; a < 2; ++a)
#pragma unroll
            for (int b = 0; b < 2; ++b)
#pragma unroll
                for (int m = 0; m < 4; ++m)
#pragma unroll
                    for (int n = 0; n < 2; ++n) acc[a][b][m][n] = (f32x4){0.f, 0.f, 0.f, 0.f};
        cur = nxt; cA = nA; cB = nB; ++ui;
        if constexpr (ALIGN_EPI) { if (wr == 1) PG8_BAR; }
    }
    PG8_WAIT_V(0);
    if constexpr (!ALIGN_EPI) { if (wr == 0) PG8_BAR; }
    PG8_BAR;
    if constexpr (Epi::AFTER_DRAIN) { E.fused(acc, cur, wr, wc, fr, fq, lds, wid, lane); S.done(cur); }
#undef PG8_SA
#undef PG8_SB
#undef PG8_STAGE
#undef PG8_LDA
#undef PG8_LDB
#undef PG8_MMA
#undef PG8_WAIT_V
#undef PG8_WAIT_L
#undef PG8_BAR
#undef PG8_SCHED
}
}

#define LAS __attribute__((address_space(3)))
typedef unsigned short bf16;
typedef short bf16x8 __attribute__((ext_vector_type(8)));
typedef short s16x4 __attribute__((ext_vector_type(4)));
typedef short v4i16_t __attribute__((ext_vector_type(4)));
typedef float f32x4 __attribute__((ext_vector_type(4)));
typedef unsigned u32x4 __attribute__((ext_vector_type(4)));
typedef unsigned u32x2 __attribute__((ext_vector_type(2)));
typedef LAS unsigned char* ldsp;

constexpr int BATCH = 8, SEQ = 8192, DM = 1024, DEPTH = 4, CHUNK = 64, MTOK = BATCH * SEQ, FF = 4096, NCH = SEQ / CHUNK;
constexpr int ABW = 2560, QKVW = 3072;
constexpr float RMS_EPS = 1e-6f, GN_EPS = 1e-5f, LOG2E = 1.4426950408889634f;
constexpr float QC2 = 0.125f * LOG2E;
constexpr int NWAVES = 8, NTHR = 512;
constexpr int LDS_BYTES = 147456;
constexpr int PITCH = 272;

constexpr size_t MiB = 1u << 20;
constexpr size_t WS_SSQ = 1000 * MiB;
constexpr size_t WS_ROT = 4 * MiB;
constexpr size_t WS_W = 8 * MiB;
constexpr size_t W_FFN = 0;
constexpr size_t W_EVEN = 64 * MiB;
constexpr size_t W_ODD = 80 * MiB;
constexpr size_t WS_XB = 104 * MiB;
constexpr size_t WS_KV = 232 * MiB;
constexpr size_t WS_BIG = 488 * MiB;
constexpr size_t WS_END = 1008 * MiB;

__device__ __forceinline__ unsigned f2bf(float f) { unsigned u = __builtin_bit_cast(unsigned, f); return (u + 0x7fffu + ((u >> 16) & 1u)) >> 16; }
typedef float f32x2_t __attribute__((ext_vector_type(2))); typedef __bf16 bf16x2_t __attribute__((ext_vector_type(2)));
__device__ __forceinline__ unsigned pk2(float lo, float hi) { const f32x2_t v = {lo, hi}; const bf16x2_t b = __builtin_convertvector(v, bf16x2_t); return __builtin_bit_cast(unsigned, b); }
__device__ __forceinline__ float bflo(unsigned u) { return __builtin_bit_cast(float, u << 16); }
__device__ __forceinline__ float bfhi(unsigned u) { return __builtin_bit_cast(float, u & 0xffff0000u); }
__device__ __forceinline__ bf16x8 lds_rd16(ldsp p) { return *(const LAS bf16x8*)p; }
__device__ __forceinline__ s16x4 lds_tr(ldsp p) { return __builtin_bit_cast(s16x4, __builtin_amdgcn_ds_read_tr16_b64_v4i16((LAS v4i16_t*)p)); }
__device__ __forceinline__ bf16x8 trfrag(ldsp p, int second_off) { const s16x4 lo = lds_tr(p), hi = lds_tr(p + second_off); return (bf16x8){lo[0], lo[1], lo[2], lo[3], hi[0], hi[1], hi[2], hi[3]}; }
__device__ __forceinline__ bf16x8 pack8(f32x4 a, f32x4 b) { u32x4 w; w.x = pk2(a[0], a[1]); w.y = pk2(a[2], a[3]); w.z = pk2(b[0], b[1]); w.w = pk2(b[2], b[3]); return __builtin_bit_cast(bf16x8, w); }
#define EX2(x) __builtin_amdgcn_exp2f(x)
#define MFMA16(a, b, c) __builtin_amdgcn_mfma_f32_16x16x32_bf16((a), (b), (c), 0, 0, 0)
__device__ __forceinline__ float wave_sum(float v) {
#pragma unroll
    for (int o = 1; o < 64; o <<= 1) v += __shfl_xor(v, o);
    return v;
}
__device__ __forceinline__ void swap16(float& a, float& b) { asm("s_nop 1\n\tv_permlane16_swap_b32 %0, %1" : "+v"(a), "+v"(b)); }
__device__ __forceinline__ void swap32(float& a, float& b) { asm("s_nop 1\n\tv_permlane32_swap_b32 %0, %1" : "+v"(a), "+v"(b)); }
__device__ __forceinline__ float xrow_sum(float v) {
    float a = v, b = v; swap16(a, b); v = a + b;
    a = v; b = v; swap32(a, b); return a + b;
}
__device__ __forceinline__ float xrow_max(float v) {
    float a = v, b = v; swap16(a, b); v = fmaxf(a, b);
    a = v; b = v; swap32(a, b); return fmaxf(a, b);
}
__device__ __forceinline__ float head_lg(int h) { asm volatile("" : "+s"(h)); return log2f(1.0f - exp2f(-5.0f - (float)h)); }

__device__ __forceinline__ float row_rstd(const float* ssq, size_t row) {
    const f32x4* p = (const f32x4*)(ssq + row * 16);
    const f32x4 a = p[0], b = p[1], c = p[2], d = p[3];
    const float s = (((a[0] + a[1]) + (a[2] + a[3])) + ((b[0] + b[1]) + (b[2] + b[3]))) + (((c[0] + c[1]) + (c[2] + c[3])) + ((d[0] + d[1]) + (d[2] + d[3])));
    return rsqrtf(s * (1.0f / DM) + RMS_EPS);
}
template <int MODE> struct EpiProj {
    static constexpr bool PERM = true, AFTER_DRAIN = false;
    bf16* O; int ldc; const float* ssq; const float* rot;
    __device__ __forceinline__ void operator()(const pg8::f32x4 (&acc)[2][2][4][2], const pg8::Unit& u, int wr, int wc, int fr, int fq) const {
        const int row0 = u.pm * 256 + wr * 64 + fr, colt = u.pn * 256 + wc * 32 + 8 * fq;
        float rstd[8];
        if (MODE == 1) {
#pragma unroll
            for (int r8 = 0; r8 < 8; ++r8) rstd[r8] = 1.0f;
        } else {
            f32x4 pr[8];
#pragma unroll
            for (int r8 = 0; r8 < 8; ++r8) pr[r8] = *(const f32x4*)(ssq + (size_t)(row0 + (r8 >> 2) * 128 + (r8 & 3) * 16) * 16 + 4 * fq);
#pragma unroll
            for (int r8 = 0; r8 < 8; ++r8) { const float s4 = xrow_sum((pr[r8][0] + pr[r8][1]) + (pr[r8][2] + pr[r8][3])); rstd[r8] = rsqrtf(s4 * (1.0f / DM) + RMS_EPS); }
        }
        if (MODE == 0 && u.pn < 4) {
            f32x4 rc[2][2][2];
            const int pairi = (colt & 127) >> 1;
#define EPI_ROT_LOAD(bt, buf) do { _Pragma("unroll") for (int rr = 0; rr < 2; ++rr) { const int r8 = (bt) * 2 + rr; const int pos = (row0 + (r8 >> 2) * 128 + (r8 & 3) * 16) & (SEQ - 1); \
                const f32x4* rp = (const f32x4*)(rot + ((size_t)pos * 64 + pairi) * 2); rc[buf][rr][0] = rp[0]; rc[buf][rr][1] = rp[1]; } } while (0)
            EPI_ROT_LOAD(0, 0);
            const float sc = (u.pn >= 2) ? 0.08838834764831845f : 1.0f;
#pragma unroll
            for (int bt = 0; bt < 4; ++bt) {
                if (bt < 3) EPI_ROT_LOAD(bt + 1, (bt + 1) & 1);
#pragma unroll
                for (int rr = 0; rr < 2; ++rr) { const int r8 = bt * 2 + rr, ai = r8 >> 2, m = r8 & 3; const int row = row0 + ai * 128 + m * 16;
                    const f32x4 c0 = rc[bt & 1][rr][0], c1 = rc[bt & 1][rr][1]; const float rs = rstd[r8] * sc;
#pragma unroll
                    for (int bj = 0; bj < 2; ++bj) {
                        const f32x4 v0 = acc[ai][bj][m][0] * rs, v1 = acc[ai][bj][m][1] * rs;
                        f32x4 r0, r1;
                        r0[0] = v0[0] * c0[0] - v0[1] * c0[1]; r0[1] = v0[0] * c0[1] + v0[1] * c0[0];
                        r0[2] = v0[2] * c0[2] - v0[3] * c0[3]; r0[3] = v0[2] * c0[3] + v0[3] * c0[2];
                        r1[0] = v1[0] * c1[0] - v1[1] * c1[1]; r1[1] = v1[0] * c1[1] + v1[1] * c1[0];
                        r1[2] = v1[2] * c1[2] - v1[3] * c1[3]; r1[3] = v1[2] * c1[3] + v1[3] * c1[2];
                        u32x4 w; w.x = pk2(r0[0], r0[1]); w.y = pk2(r0[2], r0[3]); w.z = pk2(r1[0], r1[1]); w.w = pk2(r1[2], r1[3]);
                        *(u32x4*)(O + (size_t)row * ldc + colt + bj * 128) = w;
                    } }
            }
#undef EPI_ROT_LOAD
        } else {
            const float sc = (MODE == 2 && u.pn < 4) ? QC2 : 1.0f;
#pragma unroll
            for (int r8 = 0; r8 < 8; ++r8) { const int ai = r8 >> 2, m = r8 & 3; const int row = row0 + ai * 128 + m * 16; const float rs = rstd[r8] * sc;
#pragma unroll
                for (int bj = 0; bj < 2; ++bj) {
                    f32x4 v0 = acc[ai][bj][m][0] * rs, v1 = acc[ai][bj][m][1] * rs;
                    if (MODE == 1) {
#pragma unroll
                        for (int e = 0; e < 4; ++e) { const float a = __builtin_amdgcn_fmed3f(v0[e], 0.f, __builtin_inff()), b = __builtin_amdgcn_fmed3f(v1[e], 0.f, __builtin_inff()); v0[e] = a * a; v1[e] = b * b; }
                    }
                    u32x4 w; w.x = pk2(v0[0], v0[1]); w.y = pk2(v0[2], v0[3]); w.z = pk2(v1[0], v1[1]); w.w = pk2(v1[2], v1[3]);
                    *(u32x4*)(O + (size_t)row * ldc + colt + bj * 128) = w;
                } }
        }
    }
};
struct EpiRes {
    static constexpr bool PERM = true, AFTER_DRAIN = false;
    const float* basef; float* out; bf16* xb; float* ssq_next; const float* ssq_scale;
    __device__ __forceinline__ void operator()(const pg8::f32x4 (&acc)[2][2][4][2], const pg8::Unit& u, int wr, int wc, int fr, int fq) const {
        const int row0 = u.pm * 256 + wr * 64 + fr, colt = u.pn * 256 + wc * 32 + 8 * fq;
        if (basef) {
            f32x4 bb[2][2][2];
#define EPI_RES_LOAD(r8_, buf) do { const float* bp = basef + (size_t)(row0 + ((r8_) >> 2) * 128 + ((r8_) & 3) * 16) * DM + colt; \
                _Pragma("unroll") for (int bj = 0; bj < 2; ++bj) { bb[buf][bj][0] = *(const f32x4*)(bp + bj * 128); bb[buf][bj][1] = *(const f32x4*)(bp + bj * 128 + 4); } } while (0)
            EPI_RES_LOAD(0, 0);
#pragma unroll
            for (int r8 = 0; r8 < 8; ++r8) {
                if (r8 < 7) EPI_RES_LOAD(r8 + 1, (r8 + 1) & 1);
                const int ai = r8 >> 2, m = r8 & 3; const int row = row0 + ai * 128 + m * 16;
                float sq = 0.f;
#pragma unroll
                for (int bj = 0; bj < 2; ++bj) {
                    const size_t off = (size_t)row * DM + colt + bj * 128;
                    const f32x4 v0 = acc[ai][bj][m][0] + bb[r8 & 1][bj][0], v1 = acc[ai][bj][m][1] + bb[r8 & 1][bj][1];
                    if (out) { *(f32x4*)(out + off) = v0; *(f32x4*)(out + off + 4) = v1; }
                    u32x4 w; w.x = pk2(v0[0], v0[1]); w.y = pk2(v0[2], v0[3]); w.z = pk2(v1[0], v1[1]); w.w = pk2(v1[2], v1[3]);
                    if (xb) *(u32x4*)(xb + off) = w;
                    sq += (v0[0] * v0[0] + v0[1] * v0[1]) + (v0[2] * v0[2] + v0[3] * v0[3]) + (v1[0] * v1[0] + v1[1] * v1[1]) + (v1[2] * v1[2] + v1[3] * v1[3]);
                }
                sq = xrow_sum(sq);
                if (fq == 0) ssq_next[(size_t)row * 16 + u.pn * 4 + wc] = sq;
            }
#undef EPI_RES_LOAD
        } else {
            float rf[8];
            if (ssq_scale) {
                f32x4 pr[8];
#pragma unroll
                for (int r8 = 0; r8 < 8; ++r8) pr[r8] = *(const f32x4*)(ssq_scale + (size_t)(row0 + (r8 >> 2) * 128 + (r8 & 3) * 16) * 16 + 4 * fq);
#pragma unroll
                for (int r8 = 0; r8 < 8; ++r8) { const float s4 = xrow_sum((pr[r8][0] + pr[r8][1]) + (pr[r8][2] + pr[r8][3])); rf[r8] = 1.0f / (s4 * (1.0f / DM) + RMS_EPS); }
            } else {
#pragma unroll
                for (int r8 = 0; r8 < 8; ++r8) rf[r8] = 1.0f;
            }
            u32x4 bb[2][2][2];
#define EPI_RESB_LOAD(bt, buf) do { _Pragma("unroll") for (int rr = 0; rr < 2; ++rr) { const int r8 = (bt) * 2 + rr; const bf16* bp = xb + (size_t)(row0 + (r8 >> 2) * 128 + (r8 & 3) * 16) * DM + colt; \
                bb[buf][rr][0] = *(const u32x4*)bp; bb[buf][rr][1] = *(const u32x4*)(bp + 128); } } while (0)
            EPI_RESB_LOAD(0, 0);
#pragma unroll
            for (int bt = 0; bt < 4; ++bt) {
                if (bt < 3) EPI_RESB_LOAD(bt + 1, (bt + 1) & 1);
#pragma unroll
                for (int rr = 0; rr < 2; ++rr) { const int r8 = bt * 2 + rr, ai = r8 >> 2, m = r8 & 3; const int row = row0 + ai * 128 + m * 16;
                    float sq = 0.f;
#pragma unroll
                    for (int bj = 0; bj < 2; ++bj) {
                        const size_t off = (size_t)row * DM + colt + bj * 128; const u32x4 bw = bb[bt & 1][rr][bj];
                        f32x4 v0 = acc[ai][bj][m][0] * rf[r8], v1 = acc[ai][bj][m][1] * rf[r8];
                        v0[0] += bflo(bw.x); v0[1] += bfhi(bw.x); v0[2] += bflo(bw.y); v0[3] += bfhi(bw.y); v1[0] += bflo(bw.z); v1[1] += bfhi(bw.z); v1[2] += bflo(bw.w); v1[3] += bfhi(bw.w);
                        if (out) { *(f32x4*)(out + off) = v0; *(f32x4*)(out + off + 4) = v1; }
                        else { u32x4 w; w.x = pk2(v0[0], v0[1]); w.y = pk2(v0[2], v0[3]); w.z = pk2(v1[0], v1[1]); w.w = pk2(v1[2], v1[3]); *(u32x4*)(xb + off) = w; }
                        sq += (v0[0] * v0[0] + v0[1] * v0[1]) + (v0[2] * v0[2] + v0[3] * v0[3]) + (v1[0] * v1[0] + v1[1] * v1[1]) + (v1[2] * v1[2] + v1[3] * v1[3]);
                    }
                    sq = xrow_sum(sq);
                    if (fq == 0) ssq_next[(size_t)row * 16 + u.pn * 4 + wc] = sq; }
            }
#undef EPI_RESB_LOAD
        }
    }
};
__device__ __forceinline__ void transpose_item(const float* W, int K, int N, int ldw, const float* gain, bf16* WT, LAS float* scr, int item, int lane) {
    const int nblk = N / 32, kb = item / nblk, nb = item % nblk, k0 = 64 * kb, n0 = 32 * nb;
#pragma unroll 8
    for (int i = 0; i < 32; ++i) { const int kk = 2 * i + (lane >> 5); const float gsc = gain ? gain[k0 + kk] : 1.0f; scr[kk * 33 + (lane & 31)] = W[(size_t)(k0 + kk) * ldw + n0 + (lane & 31)] * gsc; }
    asm volatile("s_waitcnt lgkmcnt(0)" ::: "memory");
    const int c = lane & 7;
#pragma unroll
    for (int j = 0; j < 4; ++j) { const int n = (lane >> 3) + 8 * j; const LAS float* s = scr + (8 * c) * 33 + n;
        u32x4 o; o.x = pk2(s[0 * 33], s[1 * 33]); o.y = pk2(s[2 * 33], s[3 * 33]); o.z = pk2(s[4 * 33], s[5 * 33]); o.w = pk2(s[6 * 33], s[7 * 33]);
        *(u32x4*)(WT + (size_t)(n0 + n) * K + k0 + 8 * c) = o; }
    asm volatile("s_waitcnt lgkmcnt(0)" ::: "memory");
}

struct Params {
    const float* x; const float* mix_norm; const float* ffn_norm; const float* w_ffn_in; const float* w_ffn_out;
    const float* ab_w_in; const float* ab_gn_gain; const float* ab_w_pool; const float* ab_pool_scale; const float* ab_w_out;
    const float* c_w_qkv; const float* c_rel_bias; const float* c_w_out; const float* final_norm;
    float* out; unsigned char* ws; int ph_lo, ph_hi;
};

__device__ __forceinline__ void prologue(const Params& P, ldsp lds, int tid, int wave, int lane, int vcu, int G) {
    unsigned char* ws = P.ws;
    bf16* Wb = (bf16*)(ws + WS_W);
    LAS float* scr = (LAS float*)(lds + wave * 16384);
    const int gw = vcu * NWAVES + wave, NGW = G * NWAVES;
    constexpr int I_FFN = 8 * 2048, I_EVEN1 = 1280 + 512 + 32, I_ODD1 = 1536 + 512, NITEMS = I_FFN + 2 * I_EVEN1 + 2 * I_ODD1;
    for (int it = gw; it < NITEMS; it += NGW) {
        int r = it;
        if (r < I_FFN) { const int mat = r >> 11, L = mat >> 1; r &= 2047;
            if ((mat & 1) == 0) transpose_item(P.w_ffn_in + (size_t)L * DM * FF, DM, FF, FF, P.ffn_norm + L * DM, Wb + (W_FFN + (size_t)L * 16 * MiB) / 2, scr, r, lane);
            else transpose_item(P.w_ffn_out + (size_t)L * FF * DM, FF, DM, DM, nullptr, Wb + (W_FFN + (size_t)L * 16 * MiB + 8 * MiB) / 2, scr, r, lane);
            continue; }
        r -= I_FFN;
        if (r < 2 * I_EVEN1) { const int i = r / I_EVEN1; r -= i * I_EVEN1; bf16* base = Wb + (W_EVEN + (size_t)i * 8 * MiB) / 2;
            if (r < 1280) { transpose_item(P.ab_w_in + (size_t)i * DM * ABW, DM, ABW, ABW, P.mix_norm + (2 * i) * DM, base, scr, r, lane); continue; }
            r -= 1280;
            if (r < 512) { transpose_item(P.ab_w_out + (size_t)i * DM * DM, DM, DM, DM, nullptr, base + (5 * MiB) / 2, scr, r, lane); continue; }
            r -= 512;
            { const int gi = r >> 3; r &= 7; transpose_item(P.ab_w_pool + ((size_t)i * 4 + gi) * 128 * 128, 128, 128, 128, nullptr, base + (7 * MiB) / 2 + gi * 128 * 128, scr, r, lane); }
            continue; }
        r -= 2 * I_EVEN1;
        { const int i = r / I_ODD1; r -= i * I_ODD1; bf16* base = Wb + (W_ODD + (size_t)i * 8 * MiB) / 2;
            if (r < 1536) transpose_item(P.c_w_qkv + (size_t)i * DM * QKVW, DM, QKVW, QKVW, P.mix_norm + (2 * i + 1) * DM, base, scr, r, lane);
            else transpose_item(P.c_w_out + (size_t)i * DM * DM, DM, DM, DM, nullptr, base + (6 * MiB) / 2, scr, r - 1536, lane); }
    }
    float* ssq = (float*)(ws + WS_SSQ);
    bf16* XB = (bf16*)(ws + WS_XB);
    for (int m0 = gw * 4; m0 < MTOK; m0 += NGW * 4) {
        f32x4 v[4][4];
#pragma unroll
        for (int r = 0; r < 4; ++r) { const f32x4* xr = (const f32x4*)(P.x + (size_t)(m0 + r) * DM) + lane;
#pragma unroll
            for (int j = 0; j < 4; ++j) v[r][j] = xr[64 * j]; }
#pragma unroll
        for (int r = 0; r < 4; ++r) { float s = 0.f; u32x2* o8 = (u32x2*)(XB + (size_t)(m0 + r) * DM) + lane;
#pragma unroll
            for (int j = 0; j < 4; ++j) { const f32x4 t = v[r][j]; s += (t[0] * t[0] + t[1] * t[1]) + (t[2] * t[2] + t[3] * t[3]); u32x2 w; w.x = pk2(t[0], t[1]); w.y = pk2(t[2], t[3]); o8[64 * j] = w; }
            s = wave_sum(s);
            if (lane < 16) ssq[(size_t)(m0 + r) * 16 + lane] = (lane == 0) ? s : 0.f; }
    }
    const int gt = vcu * NTHR + tid, NGT = G * NTHR;
    float* rot = (float*)(ws + WS_ROT);
    for (int i = gt; i < SEQ * 64; i += NGT) {
        const int pos = i >> 6, fi = i & 63;
        const float invf = (float)exp2(-(double)fi * (13.287712379549449 / 63.0));
        const float ang = (float)pos * invf;
        const double rev = (double)ang * 0.15915494309189535;
        const double fr = rev - floor(rev);
        const float a = (float)(fr * 6.283185307179586);
        rot[2 * i] = __cosf(a); rot[2 * i + 1] = __sinf(a);
    }
}

#define RET_KV_UPDATE(Kd_, Vs_) do { _Pragma("unroll") for (int ks = 0; ks < 2; ++ks) { \
        const int rowoff = (ks * 32 + g * 8 + (i >> 2)) * PITCH + 8 * (i & 3); \
        const bf16x8 Bv = trfrag((Vs_) + rowoff + wave * 32, 4 * PITCH); \
        _Pragma("unroll") for (int dt = 0; dt < 8; ++dt) { const bf16x8 Ak = trfrag((Kd_) + rowoff + dt * 32, 4 * PITCH); st[dt] = MFMA16(Ak, Bv, st[dt]); } } } while (0)
__device__ __forceinline__ void retA_phase(ldsp lds, const bf16* z, float* TS, int vcu, int G, int tid, int wave, int lane) {
    ldsp Kd = lds, Vs = lds + 64 * PITCH;
    const int i = lane & 15, g = lane >> 4, lr = tid >> 4, lc = tid & 15;
    u32x4 kreg[2], vreg[2];
    for (int unit = vcu; unit < 256; unit += G) {
        const int bh = unit >> 3, seg = unit & 7, h = bh & 3;
        const float lg = head_lg(h), cd = EX2(64.0f * lg);
        const bf16* zb = z + ((size_t)(bh >> 2) * SEQ + (size_t)seg * 1024 + lr) * ABW + h * 128 + lc * 8;
#define RA_LOAD(cc) do { _Pragma("unroll") for (int it = 0; it < 2; ++it) { const bf16* src = zb + ((size_t)(cc) * 64 + it * 32) * ABW; kreg[it] = *(const u32x4*)(src + 512); vreg[it] = *(const u32x4*)(src + 1024); } } while (0)
        RA_LOAD(0);
        f32x4 st[8];
#pragma unroll
        for (int dt = 0; dt < 8; ++dt) st[dt] = (f32x4){0.f, 0.f, 0.f, 0.f};
        for (int cc = 0; cc < 16; ++cc) {
#pragma unroll
            for (int it = 0; it < 2; ++it) {
                const int r = lr + it * 32; const float dk = EX2((float)(63 - r) * lg);
                u32x4 kk = kreg[it];
                kk.x = pk2(bflo(kk.x) * dk, bfhi(kk.x) * dk); kk.y = pk2(bflo(kk.y) * dk, bfhi(kk.y) * dk); kk.z = pk2(bflo(kk.z) * dk, bfhi(kk.z) * dk); kk.w = pk2(bflo(kk.w) * dk, bfhi(kk.w) * dk);
                *(LAS u32x4*)(Kd + r * PITCH + lc * 16) = kk; *(LAS u32x4*)(Vs + r * PITCH + lc * 16) = vreg[it];
            }
            __syncthreads();
            RA_LOAD(cc < 15 ? cc + 1 : cc);
#pragma unroll
            for (int dt = 0; dt < 8; ++dt) st[dt] = st[dt] * cd;
            RET_KV_UPDATE(Kd, Vs);
            __syncthreads();
        }
#undef RA_LOAD
        float* dst = TS + ((size_t)unit * 128 + wave * 16 + i) * 128 + g * 4;
#pragma unroll
        for (int dt = 0; dt < 8; ++dt) *(f32x4*)(dst + dt * 16) = st[dt];
    }
}

__device__ __forceinline__ void pool_phase(ldsp lds, const bf16* z, const bf16* WpT, const float* scale, bf16* CAT, int vcu, int G, int tid, int wave, int lane) {
    ldsp Ps = lds, PO = lds + 80 * PITCH;
    const int i = lane & 15, g = lane >> 4;
    const int gi = vcu & 3, wdw = 2 << gi;
    bf16x8 af[4];
#pragma unroll
    for (int ks = 0; ks < 4; ++ks) af[ks] = *(const bf16x8*)(WpT + (size_t)(gi * 128 + wave * 16 + i) * 128 + ks * 32 + g * 8);
    const f32x4 sc = *(const f32x4*)(scale + gi * 128 + wave * 16 + g * 4);
    u32x4 preg[3];
    const int nbc = BATCH * NCH;
#define POOL_LOAD(bc) do { const int c_ = (bc) & 127, b_ = (bc) >> 7; \
        _Pragma("unroll") for (int it = 0; it < 3; ++it) { const int ch = tid + it * 512, r = ch >> 4, cc = ch & 15, tok = c_ * 64 - 16 + r; preg[it] = (u32x4){0u, 0u, 0u, 0u}; \
            if (ch < 1280 && tok >= 0) preg[it] = *(const u32x4*)(z + ((size_t)b_ * SEQ + tok) * ABW + 2048 + gi * 128 + cc * 8); } } while (0)
    int bc = vcu >> 2; const int step = G >> 2;
    if (bc < nbc) POOL_LOAD(bc);
    for (; bc < nbc; bc += step) {
        const int c = bc & 127, b = bc >> 7;
        const size_t row0 = (size_t)b * SEQ + c * 64;
#pragma unroll
        for (int it = 0; it < 3; ++it) { const int ch = tid + it * 512; if (ch < 1280) *(LAS u32x4*)(Ps + (ch >> 4) * PITCH + (ch & 15) * 16) = preg[it]; }
        __syncthreads();
        if (bc + step < nbc) POOL_LOAD(bc + step);
        {
            const int t = tid >> 3, cb = (tid & 7) * 32;
            float s[16];
#pragma unroll
            for (int e = 0; e < 16; ++e) s[e] = 0.f;
            for (int jj = 0; jj < wdw; ++jj) {
                const ldsp p = Ps + (16 + t - jj) * PITCH + cb;
                const u32x4 a = *(const LAS u32x4*)p, b2 = *(const LAS u32x4*)(p + 16);
                s[0] += bflo(a.x); s[1] += bfhi(a.x); s[2] += bflo(a.y); s[3] += bfhi(a.y); s[4] += bflo(a.z); s[5] += bfhi(a.z); s[6] += bflo(a.w); s[7] += bfhi(a.w);
                s[8] += bflo(b2.x); s[9] += bfhi(b2.x); s[10] += bflo(b2.y); s[11] += bfhi(b2.y); s[12] += bflo(b2.z); s[13] += bfhi(b2.z); s[14] += bflo(b2.w); s[15] += bfhi(b2.w);
            }
            const int cnt = min(c * 64 + t + 1, wdw); const float inv = 1.0f / (float)cnt;
            const ldsp p0 = Ps + (16 + t) * PITCH + cb;
            const u32x4 a = *(const LAS u32x4*)p0, b2 = *(const LAS u32x4*)(p0 + 16);
            u32x4 o0, o1;
            o0.x = pk2(s[0] * inv - bflo(a.x), s[1] * inv - bfhi(a.x)); o0.y = pk2(s[2] * inv - bflo(a.y), s[3] * inv - bfhi(a.y));
            o0.z = pk2(s[4] * inv - bflo(a.z), s[5] * inv - bfhi(a.z)); o0.w = pk2(s[6] * inv - bflo(a.w), s[7] * inv - bfhi(a.w));
            o1.x = pk2(s[8] * inv - bflo(b2.x), s[9] * inv - bfhi(b2.x)); o1.y = pk2(s[10] * inv - bflo(b2.y), s[11] * inv - bfhi(b2.y));
            o1.z = pk2(s[12] * inv - bflo(b2.z), s[13] * inv - bfhi(b2.z)); o1.w = pk2(s[14] * inv - bflo(b2.w), s[15] * inv - bfhi(b2.w));
            *(LAS u32x4*)(PO + t * PITCH + cb) = o0; *(LAS u32x4*)(PO + t * PITCH + cb + 16) = o1;
        }
        __syncthreads();
#pragma unroll
        for (int tt = 0; tt < 4; ++tt) {
            f32x4 acc = (f32x4){0.f, 0.f, 0.f, 0.f};
#pragma unroll
            for (int ks = 0; ks < 4; ++ks) { const bf16x8 bfr = lds_rd16(PO + (tt * 16 + i) * PITCH + (ks * 32 + g * 8) * 2); acc = MFMA16(af[ks], bfr, acc); }
            acc = acc * sc;
            u32x2 w; w.x = pk2(acc[0], acc[1]); w.y = pk2(acc[2], acc[3]);
            *(u32x2*)(CAT + (row0 + tt * 16 + i) * DM + 512 + gi * 128 + wave * 16 + g * 4) = w;
        }
        __syncthreads();
    }
#undef POOL_LOAD
}

__device__ __forceinline__ void retA_pool_phase(ldsp lds, const bf16* z, float* TS, const bf16* WpT, const float* scale, bf16* CAT, int vcu, int tid, int wave, int lane) {
    ldsp Kd = lds, Vs = lds + 64 * PITCH, Ps = lds + 128 * PITCH, PO = lds + 208 * PITCH;
    const int i = lane & 15, g = lane >> 4, lr = tid >> 4, lc = tid & 15;
    const int unit = vcu, bh = unit >> 3, seg = unit & 7, h = bh & 3;
    const float lg = head_lg(h), cd = EX2(64.0f * lg);
    const bf16* zb = z + ((size_t)(bh >> 2) * SEQ + (size_t)seg * 1024 + lr) * ABW + h * 128 + lc * 8;
    u32x4 kreg[2], vreg[2];
#define RA_LOAD(cc) do { _Pragma("unroll") for (int it = 0; it < 2; ++it) { const bf16* src = zb + ((size_t)(cc) * 64 + it * 32) * ABW; kreg[it] = *(const u32x4*)(src + 512); vreg[it] = *(const u32x4*)(src + 1024); } } while (0)
    const int gi = vcu & 3, wdw = 2 << gi;
    bf16x8 af[4];
#pragma unroll
    for (int ks = 0; ks < 4; ++ks) af[ks] = *(const bf16x8*)(WpT + (size_t)(gi * 128 + wave * 16 + i) * 128 + ks * 32 + g * 8);
    const f32x4 sc = *(const f32x4*)(scale + gi * 128 + wave * 16 + g * 4);
    u32x4 preg[3];
#define POOL_LOAD(bc) do { const int c_ = (bc) & 127, b_ = (bc) >> 7; \
        _Pragma("unroll") for (int it = 0; it < 3; ++it) { const int ch = tid + it * 512, r = ch >> 4, cc = ch & 15, tok = c_ * 64 - 16 + r; preg[it] = (u32x4){0u, 0u, 0u, 0u}; \
            if (ch < 1280 && tok >= 0) preg[it] = *(const u32x4*)(z + ((size_t)b_ * SEQ + tok) * ABW + 2048 + gi * 128 + cc * 8); } } while (0)
    RA_LOAD(0); POOL_LOAD(vcu >> 2);
    f32x4 st[8];
#pragma unroll
    for (int dt = 0; dt < 8; ++dt) st[dt] = (f32x4){0.f, 0.f, 0.f, 0.f};
    for (int k = 0; k < 16; ++k) {
        const int bc = (vcu >> 2) + 64 * k, c = bc & 127, b = bc >> 7;
        const size_t row0 = (size_t)b * SEQ + c * 64;
#pragma unroll
        for (int it = 0; it < 2; ++it) {
            const int r = lr + it * 32; const float dk = EX2((float)(63 - r) * lg);
            u32x4 kk = kreg[it];
            kk.x = pk2(bflo(kk.x) * dk, bfhi(kk.x) * dk); kk.y = pk2(bflo(kk.y) * dk, bfhi(kk.y) * dk); kk.z = pk2(bflo(kk.z) * dk, bfhi(kk.z) * dk); kk.w = pk2(bflo(kk.w) * dk, bfhi(kk.w) * dk);
            *(LAS u32x4*)(Kd + r * PITCH + lc * 16) = kk; *(LAS u32x4*)(Vs + r * PITCH + lc * 16) = vreg[it];
        }
#pragma unroll
        for (int it = 0; it < 3; ++it) { const int ch = tid + it * 512; if (ch < 1280) *(LAS u32x4*)(Ps + (ch >> 4) * PITCH + (ch & 15) * 16) = preg[it]; }
        __syncthreads();
        { const int kn = (k < 15) ? k + 1 : k; RA_LOAD(kn); POOL_LOAD((vcu >> 2) + 64 * kn); }
#pragma unroll
        for (int dt = 0; dt < 8; ++dt) st[dt] = st[dt] * cd;
        RET_KV_UPDATE(Kd, Vs);
        {
            const int t = tid >> 3, cb = (tid & 7) * 32;
            float s[16];
#pragma unroll
            for (int e = 0; e < 16; ++e) s[e] = 0.f;
            for (int jj = 0; jj < wdw; ++jj) {
                const ldsp p = Ps + (16 + t - jj) * PITCH + cb;
                const u32x4 a = *(const LAS u32x4*)p, b2 = *(const LAS u32x4*)(p + 16);
                s[0] += bflo(a.x); s[1] += bfhi(a.x); s[2] += bflo(a.y); s[3] += bfhi(a.y); s[4] += bflo(a.z); s[5] += bfhi(a.z); s[6] += bflo(a.w); s[7] += bfhi(a.w);
                s[8] += bflo(b2.x); s[9] += bfhi(b2.x); s[10] += bflo(b2.y); s[11] += bfhi(b2.y); s[12] += bflo(b2.z); s[13] += bfhi(b2.z); s[14] += bflo(b2.w); s[15] += bfhi(b2.w);
            }
            const int cnt = min(c * 64 + t + 1, wdw); const float inv = 1.0f / (float)cnt;
            const ldsp p0 = Ps + (16 + t) * PITCH + cb;
            const u32x4 a = *(const LAS u32x4*)p0, b2 = *(const LAS u32x4*)(p0 + 16);
            u32x4 o0, o1;
            o0.x = pk2(s[0] * inv - bflo(a.x), s[1] * inv - bfhi(a.x)); o0.y = pk2(s[2] * inv - bflo(a.y), s[3] * inv - bfhi(a.y));
            o0.z = pk2(s[4] * inv - bflo(a.z), s[5] * inv - bfhi(a.z)); o0.w = pk2(s[6] * inv - bflo(a.w), s[7] * inv - bfhi(a.w));
            o1.x = pk2(s[8] * inv - bflo(b2.x), s[9] * inv - bfhi(b2.x)); o1.y = pk2(s[10] * inv - bflo(b2.y), s[11] * inv - bfhi(b2.y));
            o1.z = pk2(s[12] * inv - bflo(b2.z), s[13] * inv - bfhi(b2.z)); o1.w = pk2(s[14] * inv - bflo(b2.w), s[15] * inv - bfhi(b2.w));
            *(LAS u32x4*)(PO + t * PITCH + cb) = o0; *(LAS u32x4*)(PO + t * PITCH + cb + 16) = o1;
        }
        __syncthreads();
#pragma unroll
        for (int tt = 0; tt < 4; ++tt) {
            f32x4 acc = (f32x4){0.f, 0.f, 0.f, 0.f};
#pragma unroll
            for (int ks = 0; ks < 4; ++ks) { const bf16x8 bfr = lds_rd16(PO + (tt * 16 + i) * PITCH + (ks * 32 + g * 8) * 2); acc = MFMA16(af[ks], bfr, acc); }
            acc = acc * sc;
            u32x2 w; w.x = pk2(acc[0], acc[1]); w.y = pk2(acc[2], acc[3]);
            *(u32x2*)(CAT + (row0 + tt * 16 + i) * DM + 512 + gi * 128 + wave * 16 + g * 4) = w;
        }
    }
    __syncthreads();
#undef RA_LOAD
#undef POOL_LOAD
    float* dst = TS + ((size_t)unit * 128 + wave * 16 + i) * 128 + g * 4;
#pragma unroll
    for (int dt = 0; dt < 8; ++dt) *(f32x4*)(dst + dt * 16) = st[dt];
}

__device__ __forceinline__ void retB_phase(ldsp lds, const bf16* z, const float* TS, const float* gn_gain, bf16* CAT, int vcu, int G, int tid, int wave, int lane) {
    ldsp Qs = lds, Ks = lds + 64 * PITCH, Vs = lds + 128 * PITCH, Kd = lds + 256 * PITCH, STs = lds + 320 * PITCH;
    const int i = lane & 15, g = lane >> 4, nt = wave & 3, eh = wave >> 2, lr = tid >> 4, lc = tid & 15;
    u32x4 qreg[2], kreg[2], vreg[2], greg[2];
    for (int unit = vcu; unit < 256; unit += G) {
        const int bh = unit >> 3, seg = unit & 7, b = bh >> 2, h = bh & 3;
        f32x4 gg[4];
#pragma unroll
        for (int et = 0; et < 4; ++et) gg[et] = *(const f32x4*)(gn_gain + h * 128 + eh * 64 + et * 16 + g * 4);
        const float lg = head_lg(h), cd = EX2(64.0f * lg);
        const bf16* zb = z + ((size_t)b * SEQ + (size_t)seg * 1024 + lr) * ABW + h * 128 + lc * 8;
#define RB_LOAD(cc) do { _Pragma("unroll") for (int it = 0; it < 2; ++it) { const bf16* src = zb + ((size_t)(cc) * 64 + it * 32) * ABW; \
            qreg[it] = *(const u32x4*)src; kreg[it] = *(const u32x4*)(src + 512); vreg[it] = *(const u32x4*)(src + 1024); greg[it] = *(const u32x4*)(src + 1536); } } while (0)
        RB_LOAD(0);
        f32x4 st[8];
#pragma unroll
        for (int dt = 0; dt < 8; ++dt) st[dt] = (f32x4){0.f, 0.f, 0.f, 0.f};
        for (int sp = 0; sp < seg; ++sp) {
            const float wsp = EX2(1024.0f * lg * (float)(seg - 1 - sp));
            const float* src = TS + ((size_t)(bh * 8 + sp) * 128 + wave * 16 + i) * 128 + g * 4;
#pragma unroll
            for (int dt = 0; dt < 8; ++dt) st[dt] = st[dt] + *(const f32x4*)(src + dt * 16) * wsp;
        }
        for (int cc = 0; cc < 16; ++cc) {
            const size_t row0 = (size_t)b * SEQ + (size_t)(seg * 16 + cc) * 64;
            const ldsp Gs = (cc & 1) ? lds + 448 * PITCH : lds + 192 * PITCH;
            LAS float* RED = (LAS float*)(lds + 512 * PITCH) + (cc & 1) * 256;
#pragma unroll
            for (int it = 0; it < 2; ++it) { const int r = lr + it * 32, off = r * PITCH + lc * 16; const float dk = EX2((float)(63 - r) * lg);
                u32x4 kk = kreg[it];
                kk.x = pk2(bflo(kk.x) * dk, bfhi(kk.x) * dk); kk.y = pk2(bflo(kk.y) * dk, bfhi(kk.y) * dk); kk.z = pk2(bflo(kk.z) * dk, bfhi(kk.z) * dk); kk.w = pk2(bflo(kk.w) * dk, bfhi(kk.w) * dk);
                *(LAS u32x4*)(Qs + off) = qreg[it]; *(LAS u32x4*)(Ks + off) = kreg[it]; *(LAS u32x4*)(Vs + off) = vreg[it]; *(LAS u32x4*)(Gs + off) = greg[it]; *(LAS u32x4*)(Kd + off) = kk; }
#pragma unroll
            for (int dt = 0; dt < 8; ++dt) { u32x2 w; w.x = pk2(st[dt][0], st[dt][1]); w.y = pk2(st[dt][2], st[dt][3]); *(LAS u32x2*)(STs + (wave * 16 + i) * PITCH + (dt * 16 + g * 4) * 2) = w; }
            __syncthreads();
            RB_LOAD(cc < 15 ? cc + 1 : cc);
            bf16x8 qf[4];
#pragma unroll
            for (int ks = 0; ks < 4; ++ks) qf[ks] = lds_rd16(Qs + (nt * 16 + i) * PITCH + (ks * 32 + g * 8) * 2);
            f32x4 sT[4];
#pragma unroll
            for (int mt = 0; mt < 4; ++mt) { sT[mt] = (f32x4){0.f, 0.f, 0.f, 0.f};
#pragma unroll
                for (int ks = 0; ks < 4; ++ks) { const bf16x8 kf = lds_rd16(Ks + (mt * 16 + i) * PITCH + (ks * 32 + g * 8) * 2); sT[mt] = MFMA16(kf, qf[ks], sT[mt]); } }
            const int n = nt * 16 + i;
#pragma unroll
            for (int mt = 0; mt < 4; ++mt)
#pragma unroll
                for (int j = 0; j < 4; ++j) { const int m = mt * 16 + g * 4 + j; sT[mt][j] *= EX2(fabsf((float)(n - m)) * lg); }
            bf16x8 Pf[2]; Pf[0] = pack8(sT[0], sT[1]); Pf[1] = pack8(sT[2], sT[3]);
            f32x4 o[4];
            const float qd = EX2((float)(n + 1) * lg);
#pragma unroll
            for (int et = 0; et < 4; ++et) { o[et] = (f32x4){0.f, 0.f, 0.f, 0.f}; const int e0 = (eh * 4 + et) * 16;
#pragma unroll
                for (int ks = 0; ks < 4; ++ks) { const bf16x8 sf = lds_rd16(STs + (e0 + i) * PITCH + (ks * 32 + g * 8) * 2); o[et] = MFMA16(sf, qf[ks], o[et]); }
                o[et] = o[et] * qd; }
#pragma unroll
            for (int ks2 = 0; ks2 < 2; ++ks2)
#pragma unroll
                for (int et = 0; et < 4; ++et) { const int e0 = (eh * 4 + et) * 16;
                    const bf16x8 vf = trfrag(Vs + (ks2 * 32 + g * 4 + (i >> 2)) * PITCH + (e0 + 4 * (i & 3)) * 2, 16 * PITCH); o[et] = MFMA16(vf, Pf[ks2], o[et]); }
#pragma unroll
            for (int dt = 0; dt < 8; ++dt) st[dt] = st[dt] * cd;
            RET_KV_UPDATE(Kd, Vs);
            float a1 = 0.f, a2 = 0.f;
#pragma unroll
            for (int et = 0; et < 4; ++et)
#pragma unroll
                for (int j = 0; j < 4; ++j) { a1 += o[et][j]; a2 += o[et][j] * o[et][j]; }
            a1 = xrow_sum(a1); a2 = xrow_sum(a2);
            if (g == 0) { RED[(wave * 16 + i) * 2] = a1; RED[(wave * 16 + i) * 2 + 1] = a2; }
            __syncthreads();
            {
                const float pa = RED[((wave ^ 4) * 16 + i) * 2], pq = RED[((wave ^ 4) * 16 + i) * 2 + 1];
                const float mean = (a1 + pa) * (1.0f / 128.0f), var = fmaxf((a2 + pq) * (1.0f / 128.0f) - mean * mean, 0.f), rstd = rsqrtf(var + GN_EPS);
                const size_t row = row0 + n;
#pragma unroll
                for (int et = 0; et < 4; ++et) { const int e = eh * 64 + et * 16 + g * 4;
                    const u32x2 gw = *(const LAS u32x2*)(Gs + n * PITCH + e * 2);
                    const float g0 = bflo(gw.x), g1 = bfhi(gw.x), g2 = bflo(gw.y), g3 = bfhi(gw.y);
                    const float y0 = (o[et][0] - mean) * rstd * gg[et][0] * (g0 / (1.0f + __expf(-g0)));
                    const float y1 = (o[et][1] - mean) * rstd * gg[et][1] * (g1 / (1.0f + __expf(-g1)));
                    const float y2 = (o[et][2] - mean) * rstd * gg[et][2] * (g2 / (1.0f + __expf(-g2)));
                    const float y3 = (o[et][3] - mean) * rstd * gg[et][3] * (g3 / (1.0f + __expf(-g3)));
                    u32x2 w; w.x = pk2(y0, y1); w.y = pk2(y2, y3);
                    *(u32x2*)(CAT + row * DM + h * 128 + e) = w; }
            }
        }
        __syncthreads();
#undef RB_LOAD
    }
}

constexpr int KPITCH = 144, VPITCH = 160;
constexpr int ATT_BUF = 64 * KPITCH + 64 * VPITCH;
__device__ __forceinline__ void attn_phase(ldsp lds, const bf16* qkv, const float* relb, bf16* O, int vcu, int G, int tid, int wave, int lane) {
    const int head = vcu & 15;
    LAS float* BH = (LAS float*)(lds + 4 * ATT_BUF);
    for (int t2 = tid; t2 < 257; t2 += NTHR) BH[t2] = relb[head * 257 + t2] * LOG2E;
    const int i = lane & 15, g = lane >> 4, cw = wave >> 1, qh = wave & 1;
    const int lr = tid >> 3, lc = tid & 7;
    u32x4 kA, vA, kB, vB;
#define ATT_B(u_) (((u_) & 255) >> 5)
#define ATT_C0(u_) ((((u_) >> 8) * 2 + ((((u_) & 255) >> 4) & 1)) * 4)
#define ATT_T0(c0_) (((c0_) < 8) ? 0 : (c0_) - 8)
#define ATT_LOAD(KR, VR) do { const bf16* src = qkv + ((size_t)ATT_B(ul) * SEQ + (size_t)Tl * 64 + lr) * QKVW + DM + head * 64 + lc * 8; KR = *(const u32x4*)src; VR = *(const u32x4*)(src + DM); \
        if (Tl == ATT_C0(ul) + 3) { if (ul + G < 4096) { ul += G; Tl = ATT_T0(ATT_C0(ul)); } } else ++Tl; } while (0)
#define ATT_QLOAD(dst, b_, c_) do { const size_t qr_ = (size_t)(b_) * SEQ + (c_) * 64 + qh * 32 + i; \
        _Pragma("unroll") for (int qa = 0; qa < 2; ++qa) _Pragma("unroll") for (int ks = 0; ks < 2; ++ks) dst[qa][ks] = *(const bf16x8*)(qkv + (qr_ + qa * 16) * QKVW + head * 64 + ks * 32 + g * 8); } while (0)
    int u = vcu, par = 0;
    int ul = vcu, Tl = ATT_T0(ATT_C0(vcu));
    bf16x8 qf[2][2], qn[2][2];
    ATT_LOAD(kA, vA); ATT_LOAD(kB, vB);
    if (u < 4096) ATT_QLOAD(qf, ATT_B(u), ATT_C0(u) + cw);
    for (; u < 4096; u += G) {
        const int b = ATT_B(u), c0 = ATT_C0(u);
        const int c = c0 + cw;
        const int T0 = ATT_T0(c0), T1 = c0 + 3;
        const bool has_next = (u + G < 4096);
        float m_i[2] = {0.f, 0.f}, l_i[2] = {0.f, 0.f};
        const int tfirst = (c < 8) ? 8 - c : 0;
        f32x4 acc[2][4];
#pragma unroll
        for (int qa = 0; qa < 2; ++qa)
#pragma unroll
            for (int dt = 0; dt < 4; ++dt) acc[qa][dt] = (f32x4){0.f, 0.f, 0.f, 0.f};
#define ATT_STEP(Kt, T) do { \
            const ldsp Vt = (Kt) + 64 * KPITCH; \
            const int t = (T) - (c - 8);                            \
            if (t >= 0 && t <= 8) { \
                const float cb = (t <= 5) ? BH[256] : 0.f;          \
                f32x4 sT[2][4]; \
                const float i0 = cb - m_i[0], i1 = cb - m_i[1]; \
                _Pragma("unroll") for (int kt = 0; kt < 4; ++kt) { sT[0][kt] = (f32x4){i0, i0, i0, i0}; sT[1][kt] = (f32x4){i1, i1, i1, i1}; \
                    _Pragma("unroll") for (int ks = 0; ks < 2; ++ks) { const bf16x8 kf = lds_rd16(Kt + (kt * 16 + i) * KPITCH + (ks * 32 + g * 8) * 2); \
                        sT[0][kt] = MFMA16(kf, qf[0][ks], sT[0][kt]); sT[1][kt] = MFMA16(kf, qf[1][ks], sT[1][kt]); } } \
                if (t > 5) { \
                    _Pragma("unroll") for (int qa = 0; qa < 2; ++qa) { const int base = (qh * 32 + qa * 16 + i) + 640 - t * 64 - g * 4; \
                        _Pragma("unroll") for (int kt = 0; kt < 4; ++kt) \
                            _Pragma("unroll") for (int j = 0; j < 4; ++j) sT[qa][kt][j] += BH[min(base - kt * 16 - j, 256)]; } \
                } \
                bf16x8 Pb[2][2]; \
                _Pragma("unroll") for (int qa = 0; qa < 2; ++qa) { \
                    float mx = fmaxf(fmaxf(sT[qa][0][0], sT[qa][0][1]), fmaxf(sT[qa][0][2], sT[qa][0][3])); \
                    _Pragma("unroll") for (int kt = 1; kt < 4; ++kt) mx = fmaxf(mx, fmaxf(fmaxf(sT[qa][kt][0], sT[qa][kt][1]), fmaxf(sT[qa][kt][2], sT[qa][kt][3]))); \
                    mx = xrow_max(mx);                              \
                    if (t == tfirst || __any(mx > 8.0f)) {          \
                        const float dl = (t == tfirst) ? mx : fmaxf(mx, 0.f), alpha = (t == tfirst) ? 1.0f : EX2(-dl); m_i[qa] += dl;     \
                        _Pragma("unroll") for (int kt = 0; kt < 4; ++kt) sT[qa][kt] = sT[qa][kt] - dl; \
                        l_i[qa] *= alpha; \
                        _Pragma("unroll") for (int dt = 0; dt < 4; ++dt) acc[qa][dt] = acc[qa][dt] * alpha; \
                    } \
                    float rs = 0.f; \
                    _Pragma("unroll") for (int kt = 0; kt < 4; ++kt) \
                        _Pragma("unroll") for (int j = 0; j < 4; ++j) { const float p = EX2(sT[qa][kt][j]); sT[qa][kt][j] = p; rs += p; } \
                    l_i[qa] += rs; \
                    Pb[qa][0] = pack8(sT[qa][0], sT[qa][1]); Pb[qa][1] = pack8(sT[qa][2], sT[qa][3]); \
                } \
                _Pragma("unroll") for (int ks2 = 0; ks2 < 2; ++ks2) \
                    _Pragma("unroll") for (int dt = 0; dt < 4; ++dt) { const bf16x8 vf = trfrag(Vt + (ks2 * 32 + g * 4 + (i >> 2)) * VPITCH + (dt * 16 + 4 * (i & 3)) * 2, 16 * VPITCH); \
                        acc[0][dt] = MFMA16(vf, Pb[0][ks2], acc[0][dt]); acc[1][dt] = MFMA16(vf, Pb[1][ks2], acc[1][dt]); } \
            } } while (0)
        { const int un = has_next ? u + G : u; ATT_QLOAD(qn, ATT_B(un), ATT_C0(un) + cw); }
        for (int T = T0; T <= T1; T += 2) {
            const ldsp K0 = lds + (2 * par) * ATT_BUF, K1 = K0 + ATT_BUF; par ^= 1;
            *(LAS u32x4*)(K0 + lr * KPITCH + lc * 16) = kA; *(LAS u32x4*)(K0 + 64 * KPITCH + lr * VPITCH + lc * 16) = vA;
            *(LAS u32x4*)(K1 + lr * KPITCH + lc * 16) = kB; *(LAS u32x4*)(K1 + 64 * KPITCH + lr * VPITCH + lc * 16) = vB;
            __syncthreads();
            ATT_LOAD(kA, vA); ATT_LOAD(kB, vB);
            ATT_STEP(K0, T); ATT_STEP(K1, T + 1);
        }
#undef ATT_STEP
        const size_t qrow0 = (size_t)b * SEQ + c * 64 + qh * 32 + i;
#pragma unroll
        for (int qa = 0; qa < 2; ++qa) {
            const float inv = 1.0f / xrow_sum(l_i[qa]);
#pragma unroll
            for (int dt = 0; dt < 4; ++dt) { u32x2 w; w.x = pk2(acc[qa][dt][0] * inv, acc[qa][dt][1] * inv); w.y = pk2(acc[qa][dt][2] * inv, acc[qa][dt][3] * inv);
                *(u32x2*)(O + (qrow0 + qa * 16) * DM + head * 64 + dt * 16 + g * 4) = w; }
        }
#pragma unroll
        for (int qa = 0; qa < 2; ++qa)
#pragma unroll
            for (int ks = 0; ks < 2; ++ks) qf[qa][ks] = qn[qa][ks];
    }
    __syncthreads();
#undef ATT_LOAD
#undef ATT_QLOAD
#undef ATT_B
#undef ATT_C0
#undef ATT_T0
}

#define XB_TMO      128
#define XB_XCNT(j)  (256  + 64 * (j))
#define XB_XSUB(j)  (1280 + 64 * (j))
#define XB_XGEN(j)  (2304 + 64 * (j))
#define XB_TOP      3328
#define XB_TOPGEN   3392
#define XCD_BAR_WORDS 3456
#define XB_SPIN_CAP (1u << 18)

__device__ __forceinline__ unsigned xb_ld(unsigned* p)              { return __hip_atomic_load(p, __ATOMIC_RELAXED, __HIP_MEMORY_SCOPE_AGENT); }
__device__ __forceinline__ unsigned xb_add(unsigned* p, unsigned v) { return __hip_atomic_fetch_add(p, v, __ATOMIC_RELAXED, __HIP_MEMORY_SCOPE_AGENT); }
__device__ __forceinline__ unsigned xb_xcc_id() { return (unsigned)__builtin_amdgcn_s_getreg((3 << 11) | 20) & 0xFu; }
#define XB_SPIN(cond, bar) do { unsigned _sp = 0; while (cond) { __builtin_amdgcn_s_sleep(1); \
    if ((++_sp & 255u) == 0u) { if (xb_ld(&(bar)[XB_TMO])) break; if (_sp > XB_SPIN_CAP) { atomicAdd(&(bar)[XB_TMO], 1u); break; } } } } while (0)

struct XcdBarrier {
    unsigned* bar; unsigned x;
    volatile LAS unsigned* st;
};

__device__ __forceinline__ XcdBarrier xcd_barrier_post(unsigned* bar, volatile LAS unsigned* st) {
    XcdBarrier b; b.bar = bar; b.x = xb_xcc_id(); b.st = st;
    if (threadIdx.x == 0) (void)xb_add(&bar[XB_XCNT(b.x)], 1u);
    return b;
}
__device__ __forceinline__ void xcd_barrier_complete(unsigned* bar, unsigned x, unsigned& nloc, unsigned& nx) {
    const unsigned G = gridDim.x * gridDim.y * gridDim.z;
    unsigned sum, cnt, mine, sp = 0u;
    for (;;) {
        sum = 0u; cnt = 0u; mine = 0u;
#pragma unroll
        for (unsigned j = 0; j < 16; ++j) { const unsigned c = xb_ld(&bar[XB_XCNT(j)]); sum += c; cnt += (c > 0u) ? 1u : 0u; mine = (j == x) ? c : mine; }
        if (sum == G) break;
        __builtin_amdgcn_s_sleep(1);
        if ((++sp & 255u) == 0u) { if (xb_ld(&bar[XB_TMO])) break; if (sp > XB_SPIN_CAP) { atomicAdd(&bar[XB_TMO], 1u); break; } }
    }
    nloc = mine > 0u ? mine : 1u; nx = cnt > 0u ? cnt : 1u;
}

__device__ __forceinline__ void xcd_barrier(const XcdBarrier& b) {
    asm volatile("s_waitcnt vmcnt(0)" ::: "memory");
    __syncthreads();
    if (threadIdx.x == 0) {
        unsigned* bar = b.bar;
        __builtin_amdgcn_s_waitcnt(0);
        unsigned nloc = b.st[0], nx = b.st[1];
        if (nloc == 0u) { xcd_barrier_complete(bar, b.x, nloc, nx); b.st[0] = nloc; b.st[1] = nx; }
        const unsigned old = xb_add(&bar[XB_XSUB(b.x)], 1u);
        const unsigned gen = old / nloc;
        if (old + 1u == (gen + 1u) * nloc) {
            __builtin_amdgcn_fence(__ATOMIC_RELEASE, "agent");
            asm volatile("s_waitcnt vmcnt(0)" ::: "memory");
            const unsigned og = xb_add(&bar[XB_TOP], 1u);
            const unsigned tg = og / nx;
            if (og + 1u == (tg + 1u) * nx) xb_add(&bar[XB_TOPGEN], 1u);
            else XB_SPIN(xb_ld(&bar[XB_TOPGEN]) == tg, bar);
            __builtin_amdgcn_fence(__ATOMIC_ACQUIRE, "agent");
            xb_add(&bar[XB_XGEN(b.x)], 1u);
            asm volatile("s_waitcnt vmcnt(0)" ::: "memory");
        } else {
            XB_SPIN(xb_ld(&bar[XB_XGEN(b.x)]) == gen, bar);
            __builtin_amdgcn_fence(__ATOMIC_ACQUIRE, "agent");
            asm volatile("s_waitcnt vmcnt(0)" ::: "memory");
        }
    }
    __syncthreads();
}

__global__ void __launch_bounds__(NTHR, 2) fwd_megakernel(Params P) {
    extern __shared__ __attribute__((aligned(16))) unsigned char lds_raw[];
    const ldsp lds = (ldsp)lds_raw;
    cg::grid_group grid = cg::this_grid();
    const int tid0 = threadIdx.x;
    const int G = gridDim.x, bx = blockIdx.x;
    const int vcu = (G % 8 == 0) ? (bx % 8) * (G / 8) + bx / 8 : bx;
    unsigned char* ws = P.ws;
    float* ssq = (float*)(ws + WS_SSQ);
    const float* rot = (const float*)(ws + WS_ROT);
    bf16* Wb = (bf16*)(ws + WS_W);
    bf16* XB = (bf16*)(ws + WS_XB);
    float* TS = (float*)(ws + WS_KV);
    bf16* BIG = (bf16*)(ws + WS_BIG);
    bf16* Z = BIG; bf16* CAT = BIG + (size_t)MTOK * ABW;
    bf16* QKV = BIG; bf16* OB = BIG + (size_t)MTOK * QKVW;
    bf16* HB = BIG;
    const int lo = P.ph_lo, hi = P.ph_hi;
    int ph = 0;
    volatile LAS unsigned* BST = (volatile LAS unsigned*)(lds + LDS_BYTES - 64);
    if (tid0 == 0) { BST[0] = 0u; BST[1] = 0u; }
    __syncthreads();
    unsigned* barw = (unsigned*)ws;
    XcdBarrier xbar; xbar.bar = barw; xbar.x = 0; xbar.st = BST;
#ifndef PH_MASK
#define PH_MASK 0xffff
#endif
#ifndef DUP_MASK
#define DUP_MASK 0
#endif
#define PHASE_BEGIN_K(k) if (((PH_MASK >> (k)) & 1) && ph >= lo && ph < hi) { for (int rep_ = 0; rep_ < (((DUP_MASK >> (k)) & 1) ? 2 : 1); ++rep_) { int tid = tid0; asm volatile("" : "+v"(tid)); const int lane = tid & 63, wave = __builtin_amdgcn_readfirstlane(tid >> 6); (void)lane; (void)wave;
#define PHASE_END   if (ph + 1 < hi) { if (ph == 0) { asm volatile("s_waitcnt vmcnt(0) lgkmcnt(0)" ::: "memory"); grid.sync(); __builtin_amdgcn_fence(__ATOMIC_ACQUIRE, "agent"); asm volatile("s_waitcnt vmcnt(0)" ::: "memory"); \
            xbar = xcd_barrier_post(barw, BST); } else xcd_barrier(xbar); } } } ++ph;

    PHASE_BEGIN_K(0) if (bx == 0) { for (int k_ = tid; k_ < 4096; k_ += NTHR) barw[k_] = 0u; } prologue(P, lds, tid, wave, lane, vcu, G); PHASE_END

    for (int L = 0; L < DEPTH; ++L) {
        const int li = L >> 1;
        if ((L & 1) == 0) {
            const bf16* Wint = Wb + (W_EVEN + (size_t)li * 8 * MiB) / 2; const bf16* Woutt = Wint + (5 * MiB) / 2; const bf16* WpT = Wint + (7 * MiB) / 2;
            PHASE_BEGIN_K(1)
                pg8::Gemm g{XB, Wint, MTOK, ABW, DM}; pg8::StaticOrder S; S.init(MTOK, ABW, G, bx);
                EpiProj<0> E{Z, ABW, ssq, rot};
                pg8::gemm_phase<EpiProj<0>, pg8::StaticOrder, true, true>(lds, g, S, E);
            PHASE_END
            PHASE_BEGIN_K(2)
                if (G == 256) retA_pool_phase(lds, Z, TS, WpT, P.ab_pool_scale + li * 512, CAT, vcu, tid, wave, lane);
                else { retA_phase(lds, Z, TS, vcu, G, tid, wave, lane); pool_phase(lds, Z, WpT, P.ab_pool_scale + li * 512, CAT, vcu, G, tid, wave, lane); }
            PHASE_END
            PHASE_BEGIN_K(4)
                retB_phase(lds, Z, TS, P.ab_gn_gain + li * 512, CAT, vcu, G, tid, wave, lane);
            PHASE_END
            PHASE_BEGIN_K(5)
                pg8::Gemm g{CAT, Woutt, MTOK, DM, DM}; pg8::StaticOrder S; S.init(MTOK, DM, G, bx);
                EpiRes E{(L == 0) ? P.x : (const float*)nullptr, (float*)nullptr, XB, ssq + (size_t)MTOK * 16, (const float*)nullptr};
                pg8::gemm_phase<EpiRes, pg8::StaticOrder, true, true>(lds, g, S, E);
            PHASE_END
        } else {
            const bf16* Wqkvt = Wb + (W_ODD + (size_t)li * 8 * MiB) / 2; const bf16* Wot = Wqkvt + (6 * MiB) / 2;
            PHASE_BEGIN_K(6)
                pg8::Gemm g{XB, Wqkvt, MTOK, QKVW, DM}; pg8::StaticOrder S; S.init(MTOK, QKVW, G, bx);
                EpiProj<2> E{QKV, QKVW, ssq, rot};
                pg8::gemm_phase<EpiProj<2>, pg8::StaticOrder, true, true>(lds, g, S, E);
            PHASE_END
            PHASE_BEGIN_K(7)
                attn_phase(lds, QKV, P.c_rel_bias + li * 16 * 257, OB, vcu, G, tid, wave, lane);
            PHASE_END
            PHASE_BEGIN_K(8)
                pg8::Gemm g{OB, Wot, MTOK, DM, DM}; pg8::StaticOrder S; S.init(MTOK, DM, G, bx);
                EpiRes E{(L == 0) ? P.x : (const float*)nullptr, (float*)nullptr, XB, ssq + (size_t)MTOK * 16, (const float*)nullptr};
                pg8::gemm_phase<EpiRes, pg8::StaticOrder, true, true>(lds, g, S, E);
            PHASE_END
        }
        const bf16* W1t = Wb + (W_FFN + (size_t)L * 16 * MiB) / 2; const bf16* W2t = W1t + (8 * MiB) / 2;
        PHASE_BEGIN_K(9)
            pg8::Gemm g{XB, W1t, MTOK, FF, DM}; pg8::StaticOrder S; S.init(MTOK, FF, G, bx);
            EpiProj<1> E{HB, FF, ssq + (size_t)MTOK * 16, rot};
            pg8::gemm_phase<EpiProj<1>, pg8::StaticOrder, true, true>(lds, g, S, E);
        PHASE_END
        PHASE_BEGIN_K(10)
            pg8::Gemm g{HB, W2t, MTOK, DM, FF}; pg8::StaticOrder S; S.init(MTOK, DM, G, bx);
            EpiRes E{(const float*)nullptr, (L == DEPTH - 1) ? P.out : (float*)nullptr, XB, ssq, ssq + (size_t)MTOK * 16};
            pg8::gemm_phase<EpiRes, pg8::StaticOrder, true, true>(lds, g, S, E);
        PHASE_END
    }
    PHASE_BEGIN_K(11)
        const int gw = vcu * NWAVES + wave, NGW = G * NWAVES;
        const f32x4* gr = (const f32x4*)P.final_norm + lane;
        f32x4 gv[4];
#pragma unroll
        for (int j = 0; j < 4; ++j) gv[j] = gr[64 * j];
        for (int m0 = gw * 4; m0 < MTOK; m0 += NGW * 4) {
            f32x4 v[4][4]; float rs[4];
#pragma unroll
            for (int r = 0; r < 4; ++r) { const f32x4* xr = (const f32x4*)(P.out + (size_t)(m0 + r) * DM) + lane; rs[r] = row_rstd(ssq, (size_t)(m0 + r));
#pragma unroll
                for (int j = 0; j < 4; ++j) v[r][j] = xr[64 * j]; }
#pragma unroll
            for (int r = 0; r < 4; ++r) { f32x4* xo = (f32x4*)(P.out + (size_t)(m0 + r) * DM) + lane;
#pragma unroll
                for (int j = 0; j < 4; ++j) xo[64 * j] = v[r][j] * rs[r] * gv[j]; }
        }
    PHASE_END
#undef PHASE_BEGIN_K
#undef PHASE_END
}

extern "C" void kernel_launch(void* const* d_in, const int* in_sizes, int n_in, void* d_out, int out_size, void* d_ws, size_t ws_size, hipStream_t stream) {
    static int grid = 0;
    if (grid == 0) {
        if (n_in != 14 || in_sizes[0] != MTOK * DM || out_size != MTOK * DM || ws_size < WS_END) {
            fprintf(stderr, "kernel_launch: unexpected shapes/workspace: n_in %d in0 %d out %d ws %zu (need %zu)\n", n_in, n_in > 0 ? in_sizes[0] : -1, out_size, ws_size, (size_t)WS_END); grid = -1; return; }
        int dev = 0, cus = 0, per_cu = 0;
        if (hipGetDevice(&dev) != hipSuccess || hipDeviceGetAttribute(&cus, hipDeviceAttributeMultiprocessorCount, dev) != hipSuccess) { grid = -1; return; }
        if (hipFuncSetAttribute((const void*)fwd_megakernel, hipFuncAttributeMaxDynamicSharedMemorySize, LDS_BYTES) != hipSuccess) { fprintf(stderr, "kernel_launch: hipFuncSetAttribute failed\n"); grid = -1; return; }
        if (hipOccupancyMaxActiveBlocksPerMultiprocessor(&per_cu, (const void*)fwd_megakernel, NTHR, LDS_BYTES) != hipSuccess || per_cu < 1) { fprintf(stderr, "kernel_launch: occupancy query says %d\n", per_cu); per_cu = 1; }
        (void)hipGetLastError();
        grid = cus;
    }
    if (grid < 0) return;
    Params p{};
    p.x = (const float*)d_in[0]; p.mix_norm = (const float*)d_in[1]; p.ffn_norm = (const float*)d_in[2]; p.w_ffn_in = (const float*)d_in[3]; p.w_ffn_out = (const float*)d_in[4];
    p.ab_w_in = (const float*)d_in[5]; p.ab_gn_gain = (const float*)d_in[6]; p.ab_w_pool = (const float*)d_in[7]; p.ab_pool_scale = (const float*)d_in[8]; p.ab_w_out = (const float*)d_in[9];
    p.c_w_qkv = (const float*)d_in[10]; p.c_rel_bias = (const float*)d_in[11]; p.c_w_out = (const float*)d_in[12]; p.final_norm = (const float*)d_in[13];
    p.out = (float*)d_out; p.ws = (unsigned char*)d_ws; p.ph_lo = 0; p.ph_hi = 1 << 20;
    void* args[] = {&p};
    const hipError_t e = hipLaunchCooperativeKernel((const void*)fwd_megakernel, dim3(grid), dim3(NTHR), args, LDS_BYTES, stream);
    if (e != hipSuccess) fprintf(stderr, "kernel_launch: cooperative launch failed: %s (grid %d)\n", hipGetErrorString(e), grid);
}
```

```cpp
#include <hip/hip_runtime.h>
#include <hip/hip_cooperative_groups.h>
#include <cstdio>
#include <cstdint>
#include <cmath>
namespace cg = cooperative_groups;
namespace pg8 {
#define PG8_LAS __attribute__((address_space(3)))
typedef unsigned short bf16_t;
typedef short bf16x8 __attribute__((ext_vector_type(8)));
typedef float f32x4 __attribute__((ext_vector_type(4)));
typedef unsigned u32x4 __attribute__((ext_vector_type(4)));
constexpr int BM = 256, BK = 64, HALF = 128, HTB = HALF * BK * 2  , STAGE_BYTES = 8 * HTB, NXCD = 8, WGM = 8;

__host__ __device__ __forceinline__ int lds_byte(int r, int c) { const int st = (r >> 4) * 2 + (c >> 5), rr = r & 15, cc = c & 31, ob = rr * 64 + cc * 2; return st * 1024 + (ob ^ (((ob >> 9) & 1) << 5)); }
__host__ __device__ __forceinline__ void stage_rc(int b, int& R, int& C) { const int st = b / 1024, sb = b % 1024, swz = sb ^ (((sb >> 9) & 1) << 5); R = (st >> 1) * 16 + swz / 64; C = (st & 1) * 32 + (swz % 64) / 2; }
__host__ __device__ __forceinline__ int perm32(int rho) { const int n = rho >> 4, i = rho & 15; return 8 * (i >> 2) + 4 * n + (i & 3); }

struct Unit { int pm, pn; };
struct Gemm { const bf16_t* A; const bf16_t* Bt; int M, N, K; };

struct StaticOrder {
    int nM, nN, nwg, G, c;
    __host__ __device__ void init(int M, int N, int G_, int c_) { nM = M / BM; nN = N / BM; nwg = nM * nN; G = G_; c = c_; }
    __host__ __device__ bool next(int i, Unit& u) const {
        const long L = (long)i * G + c; if (L >= nwg) return false;
        int wgid = (int)L; { const int q = nwg / NXCD, r = nwg % NXCD, xcd = wgid % NXCD, off = wgid / NXCD; wgid = (xcd < r ? xcd * (q + 1) : r * (q + 1) + (xcd - r) * q) + off; }
        const int nig = WGM * nN, gid = wgid / nig, fm = gid * WGM, gsz = (nM - fm) < WGM ? (nM - fm) : WGM;
        u.pm = fm + ((wgid % nig) % gsz); u.pn = (wgid % nig) / gsz; return true;
    }
    __device__ __forceinline__ void a_ready(const Unit&) const {}
    __device__ __forceinline__ void done(const Unit&) const {}
};

template <class Epi, class Sched, bool ALIGN_EPI = false, bool SP2 = false, bool A_TILED = false>
__device__ __forceinline__ void gemm_phase(PG8_LAS unsigned char* lds, const Gemm g, const Sched& S, const Epi& E) {
    int tid = threadIdx.x; asm volatile("" : "+v"(tid));
    const int wid = __builtin_amdgcn_readfirstlane(tid >> 6), lane = tid & 63, wr = wid >> 2, wc = wid & 3, fr = lane & 15, fq = lane >> 4;
    const int K = g.K, nt = K / BK;
    unsigned voffA[2], voffB[2];
#pragma unroll
    for (int i = 0; i < 2; ++i) { int R, C; stage_rc(tid * 16 + i * 8192, R, C); const int Rb = Epi::PERM ? ((R & ~31) + perm32(R & 31)) : R;
        voffA[i] = A_TILED ? (unsigned)(((R >> 4) * (K >> 5) + (C >> 5)) * 1024 + ((R & 15) * 32 + (C & 31)) * 2) : (unsigned)(R * K + C) * 2u; voffB[i] = (unsigned)(Rb * K + C) * 2u; }
    const size_t kstep = (size_t)(BK * 2);
    const size_t kstepA = A_TILED ? (size_t)2048 : kstep;
    const size_t hstep = (size_t)HALF * K * 2;
    const size_t tstep = 2 * hstep;
    const unsigned ldsw = (unsigned)wid * 1024u;
    const int aoff = lds_byte(wr * 64 + fr, fq * 8), boff = lds_byte(wc * 32 + fr, fq * 8);
#define PG8_SA(b, h) (((b) * 2 + (h)) * HTB)
#define PG8_SB(b, h) ((4 + (b) * 2 + (h)) * HTB)
#define PG8_STAGE(bufoff, gbase, voff) do { _Pragma("unroll") for (int _i = 0; _i < 2; ++_i) \
        __builtin_amdgcn_global_load_lds((const unsigned*)((const char*)(gbase) + (voff)[_i]), (PG8_LAS unsigned*)(lds + (bufoff) + ldsw + _i * 8192), 16, 0, 0); } while (0)
#define PG8_LDA(dst, b, h) do { _Pragma("unroll") for (int m = 0; m < 4; ++m) _Pragma("unroll") for (int k = 0; k < 2; ++k) dst[m][k] = *(const PG8_LAS bf16x8*)(lds + PG8_SA(b, h) + aoff + m * 2048 + k * 1024); } while (0)
#define PG8_LDB(dst, b, h) do { _Pragma("unroll") for (int n = 0; n < 2; ++n) _Pragma("unroll") for (int k = 0; k < 2; ++k) dst[n][k] = *(const PG8_LAS bf16x8*)(lds + PG8_SB(b, h) + boff + n * 2048 + k * 1024); } while (0)
#define PG8_MMA(ai, bj, At, Bt) do { __builtin_amdgcn_s_setprio(1); _Pragma("unroll") for (int m = 0; m < 4; ++m) _Pragma("unroll") for (int n = 0; n < 2; ++n) _Pragma("unroll") for (int k = 0; k < 2; ++k) \
        acc[ai][bj][m][n] = __builtin_amdgcn_mfma_f32_16x16x32_bf16(Bt[n][k], At[m][k], acc[ai][bj][m][n], 0, 0, 0); __builtin_amdgcn_s_setprio(0); } while (0)
#define PG8_WAIT_V(n) asm volatile("s_waitcnt vmcnt(" #n ")" ::: "memory")
#define PG8_WAIT_L(n) asm volatile("s_waitcnt lgkmcnt(" #n ")" ::: "memory")
#define PG8_BAR __builtin_amdgcn_s_barrier()
#define PG8_SCHED __builtin_amdgcn_sched_barrier(0)
    Unit cur, nxt; int ui = 0;
    if (!S.next(0, cur)) return;
    f32x4 acc[2][2][4][2];
#pragma unroll
    for (int a = 0; a < 2; ++a)
#pragma unroll
        for (int b = 0; b < 2; ++b)
#pragma unroll
            for (int m = 0; m < 4; ++m)
#pragma unroll
                for (int n = 0; n < 2; ++n) acc[a][b][m][n] = (f32x4){0.f, 0.f, 0.f, 0.f};
    bf16x8 At[4][2], B0[2][2], B1[2][2];
    const char* cA = (const char*)g.A + (size_t)cur.pm * tstep; const char* cB = (const char*)g.Bt + (size_t)cur.pn * tstep;
    S.a_ready(cur);
    if constexpr (SP2) {
        PG8_STAGE(PG8_SB(0, 0), cB, voffB); PG8_STAGE(PG8_SB(0, 1), cB + hstep, voffB); PG8_STAGE(PG8_SA(0, 0), cA, voffA); PG8_STAGE(PG8_SA(0, 1), cA + hstep, voffA);
        if (wr == 1) PG8_BAR;
        PG8_WAIT_V(2); PG8_BAR;
        PG8_STAGE(PG8_SB(1, 0), cB + kstep, voffB); PG8_STAGE(PG8_SA(1, 0), cA + kstepA, voffA); PG8_STAGE(PG8_SB(1, 1), cB + hstep + kstep, voffB);
        PG8_WAIT_V(6); PG8_BAR;
    } else {
        PG8_STAGE(PG8_SB(0, 0), cB, voffB); PG8_STAGE(PG8_SA(0, 0), cA, voffA); PG8_STAGE(PG8_SB(0, 1), cB + hstep, voffB); PG8_STAGE(PG8_SA(0, 1), cA + hstep, voffA);
        if (wr == 1) PG8_BAR;
        PG8_WAIT_V(4); PG8_BAR;
        PG8_STAGE(PG8_SB(1, 0), cB + kstep, voffB); PG8_STAGE(PG8_SA(1, 0), cA + kstepA, voffA); PG8_STAGE(PG8_SB(1, 1), cB + hstep + kstep, voffB);
        PG8_WAIT_V(6); PG8_BAR;
    }
    for (;;) {
        const bool has_next = S.next(ui + 1, nxt);
        const char* nA = has_next ? (const char*)g.A + (size_t)nxt.pm * tstep : cA; const char* nB = has_next ? (const char*)g.Bt + (size_t)nxt.pn * tstep : cB;
        for (int t = 0; t < nt; t += 2) {
            const bool last = (t == nt - 2);
            const char* a1 = cA + (size_t)(t + 1) * kstepA;
            const char* a2 = last ? nA : cA + (size_t)(t + 2) * kstepA; const char* b2 = last ? nB : cB + (size_t)(t + 2) * kstep;
            const char* a3 = a2 + kstepA; const char* b3 = b2 + kstep;
            if (last && has_next) S.a_ready(nxt);
            if constexpr (SP2) {
            PG8_LDB(B0, 0, 0); PG8_LDB(B1, 0, 1); PG8_SCHED; PG8_LDA(At, 0, 0); PG8_STAGE(PG8_SA(1, 1), a1 + hstep, voffA);
            PG8_WAIT_V(8); PG8_WAIT_L(0); PG8_BAR; PG8_MMA(0, 0, At, B0); PG8_MMA(0, 1, At, B1); PG8_BAR; PG8_SCHED;
            PG8_LDA(At, 0, 1); PG8_STAGE(PG8_SB(0, 0), b2, voffB); PG8_STAGE(PG8_SB(0, 1), b2 + hstep, voffB); PG8_STAGE(PG8_SA(0, 0), a2, voffA);
            PG8_WAIT_V(8); PG8_WAIT_L(0); PG8_BAR; PG8_MMA(1, 0, At, B0); PG8_MMA(1, 1, At, B1); PG8_BAR; PG8_SCHED;
            PG8_LDB(B0, 1, 0); PG8_LDB(B1, 1, 1); PG8_SCHED; PG8_LDA(At, 1, 0); PG8_STAGE(PG8_SA(0, 1), a2 + hstep, voffA);
            PG8_WAIT_V(8); PG8_WAIT_L(0); PG8_BAR; PG8_MMA(0, 0, At, B0); PG8_MMA(0, 1, At, B1); PG8_BAR; PG8_SCHED;
            PG8_LDA(At, 1, 1); PG8_STAGE(PG8_SB(1, 0), b3, voffB); PG8_STAGE(PG8_SB(1, 1), b3 + hstep, voffB); PG8_STAGE(PG8_SA(1, 0), a3, voffA);
            PG8_WAIT_V(8); PG8_WAIT_L(0); PG8_BAR; PG8_MMA(1, 0, At, B0); PG8_MMA(1, 1, At, B1); PG8_BAR; PG8_SCHED;
            } else {
            PG8_LDB(B0, 0, 0); PG8_SCHED; PG8_LDA(At, 0, 0); PG8_STAGE(PG8_SA(1, 1), a1 + hstep, voffA);
            PG8_WAIT_L(8); PG8_BAR; PG8_WAIT_L(0); PG8_MMA(0, 0, At, B0); PG8_BAR; PG8_SCHED;
            PG8_LDB(B1, 0, 1); PG8_STAGE(PG8_SB(0, 0), b2, voffB);
            PG8_BAR; PG8_WAIT_L(0); PG8_MMA(0, 1, At, B1); PG8_BAR;
            PG8_LDA(At, 0, 1); PG8_STAGE(PG8_SA(0, 0), a2, voffA);
            PG8_BAR; PG8_WAIT_L(0); PG8_MMA(1, 0, At, B0); PG8_BAR; PG8_SCHED;
            PG8_STAGE(PG8_SB(0, 1), b2 + hstep, voffB);
            PG8_WAIT_V(6); PG8_BAR; PG8_MMA(1, 1, At, B1); PG8_BAR;
            PG8_LDB(B0, 1, 0); PG8_SCHED; PG8_LDA(At, 1, 0); PG8_STAGE(PG8_SA(0, 1), a2 + hstep, voffA);
            PG8_WAIT_L(8); PG8_BAR; PG8_WAIT_L(0); PG8_MMA(0, 0, At, B0); PG8_BAR; PG8_SCHED;
            PG8_LDB(B1, 1, 1); PG8_STAGE(PG8_SB(1, 0), b3, voffB);
            PG8_BAR; PG8_WAIT_L(0); PG8_MMA(0, 1, At, B1); PG8_BAR;
            PG8_LDA(At, 1, 1); PG8_STAGE(PG8_SA(1, 0), a3, voffA);
            PG8_BAR; PG8_WAIT_L(0); PG8_MMA(1, 0, At, B0); PG8_BAR; PG8_SCHED;
            PG8_STAGE(PG8_SB(1, 1), b3 + hstep, voffB);
            PG8_WAIT_V(6); PG8_BAR; PG8_MMA(1, 1, At, B1); PG8_BAR;
            }
        }
        if constexpr (ALIGN_EPI) { if (wr == 0) PG8_BAR; }
        if constexpr (!Epi::AFTER_DRAIN) { E(acc, cur, wr, wc, fr, fq); S.done(cur); }
        if (!has_next) break;
#pragma unroll
        for (int a = 0; a < 2; ++a)
#pragma unroll
            for (int b = 0; b < 2; ++b)
#pragma unroll
                for (int m = 0; m < 4; ++m)
#pragma unroll
                    for (int n = 0; n < 2; ++n) acc[a][b][m][n] = (f32x4){0.f, 0.f, 0.f, 0.f};
        cur = nxt; cA = nA; cB = nB; ++ui;
        if constexpr (ALIGN_EPI) { if (wr == 1) PG8_BAR; }
    }
    PG8_WAIT_V(0);
    if constexpr (!ALIGN_EPI) { if (wr == 0) PG8_BAR; }
    PG8_BAR;
    if constexpr (Epi::AFTER_DRAIN) { E.fused(acc, cur, wr, wc, fr, fq, lds, wid, lane); S.done(cur); }
#undef PG8_SA
#undef PG8_SB
#undef PG8_STAGE
#undef PG8_LDA
#undef PG8_LDB
#undef PG8_MMA
#undef PG8_WAIT_V
#undef PG8_WAIT_L
#undef PG8_BAR
#undef PG8_SCHED
}
}

#define LAS __attribute__((address_space(3)))
typedef unsigned short bf16;
typedef short bf16x8 __attribute__((ext_vector_type(8)));
typedef short s16x4 __attribute__((ext_vector_type(4)));
typedef short v4i16_t __attribute__((ext_vector_type(4)));
typedef float f32x4 __attribute__((ext_vector_type(4)));
typedef unsigned u32x4 __attribute__((ext_vector_type(4)));
typedef unsigned u32x2 __attribute__((ext_vector_type(2)));
typedef LAS unsigned char* ldsp;

constexpr int BATCH = 8, SEQ = 8192, DM = 1024, DEPTH = 4, CHUNK = 64, MTOK = BATCH * SEQ, FF = 4096, NCH = SEQ / CHUNK;
constexpr int ABW = 2560, QKVW = 3072;
constexpr float RMS_EPS = 1e-6f, GN_EPS = 1e-5f, LOG2E = 1.4426950408889634f;
constexpr float QC2 = 0.125f * LOG2E;
constexpr int NWAVES = 8, NTHR = 512;
constexpr int LDS_BYTES = 147456;
constexpr int PITCH = 272;

constexpr size_t MiB = 1u << 20;
constexpr size_t WS_SSQ = 1000 * MiB;
constexpr size_t WS_ROT = 4 * MiB;
constexpr size_t WS_W = 8 * MiB;
constexpr size_t W_FFN = 0;
constexpr size_t W_EVEN = 64 * MiB;
constexpr size_t W_ODD = 80 * MiB;
constexpr size_t WS_XB = 104 * MiB;
constexpr size_t WS_KV = 232 * MiB;
constexpr size_t WS_BIG = 488 * MiB;
constexpr size_t WS_END = 1008 * MiB;

__device__ __forceinline__ unsigned f2bf(float f) { unsigned u = __builtin_bit_cast(unsigned, f); return (u + 0x7fffu + ((u >> 16) & 1u)) >> 16; }
typedef float f32x2_t __attribute__((ext_vector_type(2))); typedef __bf16 bf16x2_t __attribute__((ext_vector_type(2)));
__device__ __forceinline__ unsigned pk2(float lo, float hi) { const f32x2_t v = {lo, hi}; const bf16x2_t b = __builtin_convertvector(v, bf16x2_t); return __builtin_bit_cast(unsigned, b); }
__device__ __forceinline__ float bflo(unsigned u) { return __builtin_bit_cast(float, u << 16); }
__device__ __forceinline__ float bfhi(unsigned u) { return __builtin_bit_cast(float, u & 0xffff0000u); }
__device__ __forceinline__ bf16x8 lds_rd16(ldsp p) { return *(const LAS bf16x8*)p; }
__device__ __forceinline__ s16x4 lds_tr(ldsp p) { return __builtin_bit_cast(s16x4, __builtin_amdgcn_ds_read_tr16_b64_v4i16((LAS v4i16_t*)p)); }
__device__ __forceinline__ bf16x8 trfrag(ldsp p, int second_off) { const s16x4 lo = lds_tr(p), hi = lds_tr(p + second_off); return (bf16x8){lo[0], lo[1], lo[2], lo[3], hi[0], hi[1], hi[2], hi[3]}; }
__device__ __forceinline__ bf16x8 pack8(f32x4 a, f32x4 b) { u32x4 w; w.x = pk2(a[0], a[1]); w.y = pk2(a[2], a[3]); w.z = pk2(b[0], b[1]); w.w = pk2(b[2], b[3]); return __builtin_bit_cast(bf16x8, w); }
#define EX2(x) __builtin_amdgcn_exp2f(x)
#define MFMA16(a, b, c) __builtin_amdgcn_mfma_f32_16x16x32_bf16((a), (b), (c), 0, 0, 0)
__device__ __forceinline__ float wave_sum(float v) {
#pragma unroll
    for (int o = 1; o < 64; o <<= 1) v += __shfl_xor(v, o);
    return v;
}
__device__ __forceinline__ void swap16(float& a, float& b) { asm("s_nop 1\n\tv_permlane16_swap_b32 %0, %1" : "+v"(a), "+v"(b)); }
__device__ __forceinline__ void swap32(float& a, float& b) { asm("s_nop 1\n\tv_permlane32_swap_b32 %0, %1" : "+v"(a), "+v"(b)); }
__device__ __forceinline__ float xrow_sum(float v) {
    float a = v, b = v; swap16(a, b); v = a + b;
    a = v; b = v; swap32(a, b); return a + b;
}
__device__ __forceinline__ float xrow_max(float v) {
    float a = v, b = v; swap16(a, b); v = fmaxf(a, b);
    a = v; b = v; swap32(a, b); return fmaxf(a, b);
}
__device__ __forceinline__ float head_lg(int h) { asm volatile("" : "+s"(h)); return log2f(1.0f - exp2f(-5.0f - (float)h)); }

__device__ __forceinline__ float row_rstd(const float* ssq, size_t row) {
    const f32x4* p = (const f32x4*)(ssq + row * 16);
    const f32x4 a = p[0], b = p[1], c = p[2], d = p[3];
    const float s = (((a[0] + a[1]) + (a[2] + a[3])) + ((b[0] + b[1]) + (b[2] + b[3]))) + (((c[0] + c[1]) + (c[2] + c[3])) + ((d[0] + d[1]) + (d[2] + d[3])));
    return rsqrtf(s * (1.0f / DM) + RMS_EPS);
}
template <int MODE> struct EpiProj {
    static constexpr bool PERM = true, AFTER_DRAIN = false;
    bf16* O; int ldc; const float* ssq; const float* rot;
    __device__ __forceinline__ void operator()(const pg8::f32x4 (&acc)[2][2][4][2], const pg8::Unit& u, int wr, int wc, int fr, int fq) const {
        const int row0 = u.pm * 256 + wr * 64 + fr, colt = u.pn * 256 + wc * 32 + 8 * fq;
        float rstd[8];
        if (MODE == 1) {
#pragma unroll
            for (int r8 = 0; r8 < 8; ++r8) rstd[r8] = 1.0f;
        } else {
            f32x4 pr[8];
#pragma unroll
            for (int r8 = 0; r8 < 8; ++r8) pr[r8] = *(const f32x4*)(ssq + (size_t)(row0 + (r8 >> 2) * 128 + (r8 & 3) * 16) * 16 + 4 * fq);
#pragma unroll
            for (int r8 = 0; r8 < 8; ++r8) { const float s4 = xrow_sum((pr[r8][0] + pr[r8][1]) + (pr[r8][2] + pr[r8][3])); rstd[r8] = rsqrtf(s4 * (1.0f / DM) + RMS_EPS); }
        }
        if (MODE == 0 && u.pn < 4) {
            f32x4 rc[2][2][2];
            const int pairi = (colt & 127) >> 1;
#define EPI_ROT_LOAD(bt, buf) do { _Pragma("unroll") for (int rr = 0; rr < 2; ++rr) { const int r8 = (bt) * 2 + rr; const int pos = (row0 + (r8 >> 2) * 128 + (r8 & 3) * 16) & (SEQ - 1); \
                const f32x4* rp = (const f32x4*)(rot + ((size_t)pos * 64 + pairi) * 2); rc[buf][rr][0] = rp[0]; rc[buf][rr][1] = rp[1]; } } while (0)
            EPI_ROT_LOAD(0, 0);
            const float sc = (u.pn >= 2) ? 0.08838834764831845f : 1.0f;
#pragma unroll
            for (int bt = 0; bt < 4; ++bt) {
                if (bt < 3) EPI_ROT_LOAD(bt + 1, (bt + 1) & 1);
#pragma unroll
                for (int rr = 0; rr < 2; ++rr) { const int r8 = bt * 2 + rr, ai = r8 >> 2, m = r8 & 3; const int row = row0 + ai * 128 + m * 16;
                    const f32x4 c0 = rc[bt & 1][rr][0], c1 = rc[bt & 1][rr][1]; const float rs = rstd[r8] * sc;
#pragma unroll
                    for (int bj = 0; bj < 2; ++bj) {
                        const f32x4 v0 = acc[ai][bj][m][0] * rs, v1 = acc[ai][bj][m][1] * rs;
                        f32x4 r0, r1;
                        r0[0] = v0[0] * c0[0] - v0[1] * c0[1]; r0[1] = v0[0] * c0[1] + v0[1] * c0[0];
                        r0[2] = v0[2] * c0[2] - v0[3] * c0[3]; r0[3] = v0[2] * c0[3] + v0[3] * c0[2];
                        r1[0] = v1[0] * c1[0] - v1[1] * c1[1]; r1[1] = v1[0] * c1[1] + v1[1] * c1[0];
                        r1[2] = v1[2] * c1[2] - v1[3] * c1[3]; r1[3] = v1[2] * c1[3] + v1[3] * c1[2];
                        u32x4 w; w.x = pk2(r0[0], r0[1]); w.y = pk2(r0[2], r0[3]); w.z = pk2(r1[0], r1[1]); w.w = pk2(r1[2], r1[3]);
                        *(u32x4*)(O + (size_t)row * ldc + colt + bj * 128) = w;
                    } }
            }
#undef EPI_ROT_LOAD
        } else {
            const float sc = (MODE == 2 && u.pn < 4) ? QC2 : 1.0f;
#pragma unroll
            for (int r8 = 0; r8 < 8; ++r8) { const int ai = r8 >> 2, m = r8 & 3; const int row = row0 + ai * 128 + m * 16; const float rs = rstd[r8] * sc;
#pragma unroll
                for (int bj = 0; bj < 2; ++bj) {
                    f32x4 v0 = acc[ai][bj][m][0] * rs, v1 = acc[ai][bj][m][1] * rs;
                    if (MODE == 1) {
#pragma unroll
                        for (int e = 0; e < 4; ++e) { const float a = fmaxf(v0[e], 0.f), b = fmaxf(v1[e], 0.f); v0[e] = a * a; v1[e] = b * b; }
                    }
                    u32x4 w; w.x = pk2(v0[0], v0[1]); w.y = pk2(v0[2], v0[3]); w.z = pk2(v1[0], v1[1]); w.w = pk2(v1[2], v1[3]);
                    if (MODE == 1) { const int col = colt + bj * 128;
                        *(u32x4*)(O + ((size_t)(row >> 4) * (ldc >> 5) + (col >> 5)) * 512 + (row & 15) * 32 + (col & 31)) = w; }
                    else *(u32x4*)(O + (size_t)row * ldc + colt + bj * 128) = w;
                } }
        }
    }
};
struct EpiRes {
    static constexpr bool PERM = true, AFTER_DRAIN = false;
    const float* basef; float* out; bf16* xb; float* ssq_next; const float* ssq_scale;
    __device__ __forceinline__ void operator()(const pg8::f32x4 (&acc)[2][2][4][2], const pg8::Unit& u, int wr, int wc, int fr, int fq) const {
        const int row0 = u.pm * 256 + wr * 64 + fr, colt = u.pn * 256 + wc * 32 + 8 * fq;
        if (basef) {
            f32x4 bb[2][2][2];
#define EPI_RES_LOAD(r8_, buf) do { const float* bp = basef + (size_t)(row0 + ((r8_) >> 2) * 128 + ((r8_) & 3) * 16) * DM + colt; \
                _Pragma("unroll") for (int bj = 0; bj < 2; ++bj) { bb[buf][bj][0] = *(const f32x4*)(bp + bj * 128); bb[buf][bj][1] = *(const f32x4*)(bp + bj * 128 + 4); } } while (0)
            EPI_RES_LOAD(0, 0);
#pragma unroll
            for (int r8 = 0; r8 < 8; ++r8) {
                if (r8 < 7) EPI_RES_LOAD(r8 + 1, (r8 + 1) & 1);
                const int ai = r8 >> 2, m = r8 & 3; const int row = row0 + ai * 128 + m * 16;
                float sq = 0.f;
#pragma unroll
                for (int bj = 0; bj < 2; ++bj) {
                    const size_t off = (size_t)row * DM + colt + bj * 128;
                    const f32x4 v0 = acc[ai][bj][m][0] + bb[r8 & 1][bj][0], v1 = acc[ai][bj][m][1] + bb[r8 & 1][bj][1];
                    if (out) { *(f32x4*)(out + off) = v0; *(f32x4*)(out + off + 4) = v1; }
                    u32x4 w; w.x = pk2(v0[0], v0[1]); w.y = pk2(v0[2], v0[3]); w.z = pk2(v1[0], v1[1]); w.w = pk2(v1[2], v1[3]);
                    if (xb) *(u32x4*)(xb + off) = w;
                    sq += (v0[0] * v0[0] + v0[1] * v0[1]) + (v0[2] * v0[2] + v0[3] * v0[3]) + (v1[0] * v1[0] + v1[1] * v1[1]) + (v1[2] * v1[2] + v1[3] * v1[3]);
                }
                sq = xrow_sum(sq);
                if (fq == 0) ssq_next[(size_t)row * 16 + u.pn * 4 + wc] = sq;
            }
#undef EPI_RES_LOAD
        } else {
            float rf[8];
            if (ssq_scale) {
                f32x4 pr[8];
#pragma unroll
                for (int r8 = 0; r8 < 8; ++r8) pr[r8] = *(const f32x4*)(ssq_scale + (size_t)(row0 + (r8 >> 2) * 128 + (r8 & 3) * 16) * 16 + 4 * fq);
#pragma unroll
                for (int r8 = 0; r8 < 8; ++r8) { const float s4 = xrow_sum((pr[r8][0] + pr[r8][1]) + (pr[r8][2] + pr[r8][3])); rf[r8] = 1.0f / (s4 * (1.0f / DM) + RMS_EPS); }
            } else {
#pragma unroll
                for (int r8 = 0; r8 < 8; ++r8) rf[r8] = 1.0f;
            }
            u32x4 bb[2][2][2];
#define EPI_RESB_LOAD(bt, buf) do { _Pragma("unroll") for (int rr = 0; rr < 2; ++rr) { const int r8 = (bt) * 2 + rr; const bf16* bp = xb + (size_t)(row0 + (r8 >> 2) * 128 + (r8 & 3) * 16) * DM + colt; \
                bb[buf][rr][0] = *(const u32x4*)bp; bb[buf][rr][1] = *(const u32x4*)(bp + 128); } } while (0)
            EPI_RESB_LOAD(0, 0);
#pragma unroll
            for (int bt = 0; bt < 4; ++bt) {
                if (bt < 3) EPI_RESB_LOAD(bt + 1, (bt + 1) & 1);
#pragma unroll
                for (int rr = 0; rr < 2; ++rr) { const int r8 = bt * 2 + rr, ai = r8 >> 2, m = r8 & 3; const int row = row0 + ai * 128 + m * 16;
                    float sq = 0.f;
#pragma unroll
                    for (int bj = 0; bj < 2; ++bj) {
                        const size_t off = (size_t)row * DM + colt + bj * 128; const u32x4 bw = bb[bt & 1][rr][bj];
                        f32x4 v0 = acc[ai][bj][m][0] * rf[r8], v1 = acc[ai][bj][m][1] * rf[r8];
                        v0[0] += bflo(bw.x); v0[1] += bfhi(bw.x); v0[2] += bflo(bw.y); v0[3] += bfhi(bw.y); v1[0] += bflo(bw.z); v1[1] += bfhi(bw.z); v1[2] += bflo(bw.w); v1[3] += bfhi(bw.w);
                        if (out) { *(f32x4*)(out + off) = v0; *(f32x4*)(out + off + 4) = v1; }
                        else { u32x4 w; w.x = pk2(v0[0], v0[1]); w.y = pk2(v0[2], v0[3]); w.z = pk2(v1[0], v1[1]); w.w = pk2(v1[2], v1[3]); *(u32x4*)(xb + off) = w; }
                        sq += (v0[0] * v0[0] + v0[1] * v0[1]) + (v0[2] * v0[2] + v0[3] * v0[3]) + (v1[0] * v1[0] + v1[1] * v1[1]) + (v1[2] * v1[2] + v1[3] * v1[3]);
                    }
                    sq = xrow_sum(sq);
                    if (fq == 0) ssq_next[(size_t)row * 16 + u.pn * 4 + wc] = sq; }
            }
#undef EPI_RESB_LOAD
        }
    }
};
__device__ __forceinline__ void transpose_item(const float* W, int K, int N, int ldw, const float* gain, bf16* WT, LAS float* scr, int item, int lane) {
    const int nblk = N / 32, kb = item / nblk, nb = item % nblk, k0 = 64 * kb, n0 = 32 * nb;
#pragma unroll 8
    for (int i = 0; i < 32; ++i) { const int kk = 2 * i + (lane >> 5); const float gsc = gain ? gain[k0 + kk] : 1.0f; scr[kk * 33 + (lane & 31)] = W[(size_t)(k0 + kk) * ldw + n0 + (lane & 31)] * gsc; }
    asm volatile("s_waitcnt lgkmcnt(0)" ::: "memory");
    const int c = lane & 7;
#pragma unroll
    for (int j = 0; j < 4; ++j) { const int n = (lane >> 3) + 8 * j; const LAS float* s = scr + (8 * c) * 33 + n;
        u32x4 o; o.x = pk2(s[0 * 33], s[1 * 33]); o.y = pk2(s[2 * 33], s[3 * 33]); o.z = pk2(s[4 * 33], s[5 * 33]); o.w = pk2(s[6 * 33], s[7 * 33]);
        *(u32x4*)(WT + (size_t)(n0 + n) * K + k0 + 8 * c) = o; }
    asm volatile("s_waitcnt lgkmcnt(0)" ::: "memory");
}

struct Params {
    const float* x; const float* mix_norm; const float* ffn_norm; const float* w_ffn_in; const float* w_ffn_out;
    const float* ab_w_in; const float* ab_gn_gain; const float* ab_w_pool; const float* ab_pool_scale; const float* ab_w_out;
    const float* c_w_qkv; const float* c_rel_bias; const float* c_w_out; const float* final_norm;
    float* out; unsigned char* ws; int ph_lo, ph_hi;
};

__device__ __forceinline__ void prologue(const Params& P, ldsp lds, int tid, int wave, int lane, int vcu, int G) {
    unsigned char* ws = P.ws;
    bf16* Wb = (bf16*)(ws + WS_W);
    LAS float* scr = (LAS float*)(lds + wave * 16384);
    const int gw = vcu * NWAVES + wave, NGW = G * NWAVES;
    constexpr int I_FFN = 8 * 2048, I_EVEN1 = 1280 + 512 + 32, I_ODD1 = 1536 + 512, NITEMS = I_FFN + 2 * I_EVEN1 + 2 * I_ODD1;
    for (int it = gw; it < NITEMS; it += NGW) {
        int r = it;
        if (r < I_FFN) { const int mat = r >> 11, L = mat >> 1; r &= 2047;
            if ((mat & 1) == 0) transpose_item(P.w_ffn_in + (size_t)L * DM * FF, DM, FF, FF, P.ffn_norm + L * DM, Wb + (W_FFN + (size_t)L * 16 * MiB) / 2, scr, r, lane);
            else transpose_item(P.w_ffn_out + (size_t)L * FF * DM, FF, DM, DM, nullptr, Wb + (W_FFN + (size_t)L * 16 * MiB + 8 * MiB) / 2, scr, r, lane);
            continue; }
        r -= I_FFN;
        if (r < 2 * I_EVEN1) { const int i = r / I_EVEN1; r -= i * I_EVEN1; bf16* base = Wb + (W_EVEN + (size_t)i * 8 * MiB) / 2;
            if (r < 1280) { transpose_item(P.ab_w_in + (size_t)i * DM * ABW, DM, ABW, ABW, P.mix_norm + (2 * i) * DM, base, scr, r, lane); continue; }
            r -= 1280;
            if (r < 512) { transpose_item(P.ab_w_out + (size_t)i * DM * DM, DM, DM, DM, nullptr, base + (5 * MiB) / 2, scr, r, lane); continue; }
            r -= 512;
            { const int gi = r >> 3; r &= 7; transpose_item(P.ab_w_pool + ((size_t)i * 4 + gi) * 128 * 128, 128, 128, 128, nullptr, base + (7 * MiB) / 2 + gi * 128 * 128, scr, r, lane); }
            continue; }
        r -= 2 * I_EVEN1;
        { const int i = r / I_ODD1; r -= i * I_ODD1; bf16* base = Wb + (W_ODD + (size_t)i * 8 * MiB) / 2;
            if (r < 1536) transpose_item(P.c_w_qkv + (size_t)i * DM * QKVW, DM, QKVW, QKVW, P.mix_norm + (2 * i + 1) * DM, base, scr, r, lane);
            else transpose_item(P.c_w_out + (size_t)i * DM * DM, DM, DM, DM, nullptr, base + (6 * MiB) / 2, scr, r - 1536, lane); }
    }
    float* ssq = (float*)(ws + WS_SSQ);
    bf16* XB = (bf16*)(ws + WS_XB);
    for (int m0 = gw * 4; m0 < MTOK; m0 += NGW * 4) {
        f32x4 v[4][4];
#pragma unroll
        for (int r = 0; r < 4; ++r) { const f32x4* xr = (const f32x4*)(P.x + (size_t)(m0 + r) * DM) + lane;
#pragma unroll
            for (int j = 0; j < 4; ++j) v[r][j] = xr[64 * j]; }
#pragma unroll
        for (int r = 0; r < 4; ++r) { float s = 0.f; u32x2* o8 = (u32x2*)(XB + (size_t)(m0 + r) * DM) + lane;
#pragma unroll
            for (int j = 0; j < 4; ++j) { const f32x4 t = v[r][j]; s += (t[0] * t[0] + t[1] * t[1]) + (t[2] * t[2] + t[3] * t[3]); u32x2 w; w.x = pk2(t[0], t[1]); w.y = pk2(t[2], t[3]); o8[64 * j] = w; }
            s = wave_sum(s);
            if (lane < 16) ssq[(size_t)(m0 + r) * 16 + lane] = (lane == 0) ? s : 0.f; }
    }
    const int gt = vcu * NTHR + tid, NGT = G * NTHR;
    float* rot = (float*)(ws + WS_ROT);
    for (int i = gt; i < SEQ * 64; i += NGT) {
        const int pos = i >> 6, fi = i & 63;
        const float invf = (float)exp2(-(double)fi * (13.287712379549449 / 63.0));
        const float ang = (float)pos * invf;
        const double rev = (double)ang * 0.15915494309189535;
        const double fr = rev - floor(rev);
        const float a = (float)(fr * 6.283185307179586);
        rot[2 * i] = __cosf(a); rot[2 * i + 1] = __sinf(a);
    }
}

#define RET_KV_UPDATE(Kd_, Vs_) do { _Pragma("unroll") for (int ks = 0; ks < 2; ++ks) { \
        const int rowoff = (ks * 32 + g * 8 + (i >> 2)) * PITCH + 8 * (i & 3); \
        const bf16x8 Bv = trfrag((Vs_) + rowoff + wave * 32, 4 * PITCH); \
        _Pragma("unroll") for (int dt = 0; dt < 8; ++dt) { const bf16x8 Ak = trfrag((Kd_) + rowoff + dt * 32, 4 * PITCH); st[dt] = MFMA16(Ak, Bv, st[dt]); } } } while (0)
__device__ __forceinline__ void retA_phase(ldsp lds, const bf16* z, float* TS, int vcu, int G, int tid, int wave, int lane) {
    ldsp Kd = lds, Vs = lds + 64 * PITCH;
    const int i = lane & 15, g = lane >> 4, lr = tid >> 4, lc = tid & 15;
    u32x4 kreg[2], vreg[2];
    for (int unit = vcu; unit < 256; unit += G) {
        const int bh = unit >> 3, seg = unit & 7, h = bh & 3;
        const float lg = head_lg(h), cd = EX2(64.0f * lg);
        const bf16* zb = z + ((size_t)(bh >> 2) * SEQ + (size_t)seg * 1024 + lr) * ABW + h * 128 + lc * 8;
#define RA_LOAD(cc) do { _Pragma("unroll") for (int it = 0; it < 2; ++it) { const bf16* src = zb + ((size_t)(cc) * 64 + it * 32) * ABW; kreg[it] = *(const u32x4*)(src + 512); vreg[it] = *(const u32x4*)(src + 1024); } } while (0)
        RA_LOAD(0);
        f32x4 st[8];
#pragma unroll
        for (int dt = 0; dt < 8; ++dt) st[dt] = (f32x4){0.f, 0.f, 0.f, 0.f};
        for (int cc = 0; cc < 16; ++cc) {
#pragma unroll
            for (int it = 0; it < 2; ++it) {
                const int r = lr + it * 32; const float dk = EX2((float)(63 - r) * lg);
                u32x4 kk = kreg[it];
                kk.x = pk2(bflo(kk.x) * dk, bfhi(kk.x) * dk); kk.y = pk2(bflo(kk.y) * dk, bfhi(kk.y) * dk); kk.z = pk2(bflo(kk.z) * dk, bfhi(kk.z) * dk); kk.w = pk2(bflo(kk.w) * dk, bfhi(kk.w) * dk);
                *(LAS u32x4*)(Kd + r * PITCH + lc * 16) = kk; *(LAS u32x4*)(Vs + r * PITCH + lc * 16) = vreg[it];
            }
            __syncthreads();
            RA_LOAD(cc < 15 ? cc + 1 : cc);
#pragma unroll
            for (int dt = 0; dt < 8; ++dt) st[dt] = st[dt] * cd;
            RET_KV_UPDATE(Kd, Vs);
            __syncthreads();
        }
#undef RA_LOAD
        float* dst = TS + ((size_t)unit * 128 + wave * 16 + i) * 128 + g * 4;
#pragma unroll
        for (int dt = 0; dt < 8; ++dt) *(f32x4*)(dst + dt * 16) = st[dt];
    }
}

__device__ __forceinline__ void pool_phase(ldsp lds, const bf16* z, const bf16* WpT, const float* scale, bf16* CAT, int vcu, int G, int tid, int wave, int lane) {
    ldsp Ps = lds, PO = lds + 80 * PITCH;
    const int i = lane & 15, g = lane >> 4;
    const int gi = vcu & 3, wdw = 2 << gi;
    bf16x8 af[4];
#pragma unroll
    for (int ks = 0; ks < 4; ++ks) af[ks] = *(const bf16x8*)(WpT + (size_t)(gi * 128 + wave * 16 + i) * 128 + ks * 32 + g * 8);
    const f32x4 sc = *(const f32x4*)(scale + gi * 128 + wave * 16 + g * 4);
    u32x4 preg[3];
    const int nbc = BATCH * NCH;
#define POOL_LOAD(bc) do { const int c_ = (bc) & 127, b_ = (bc) >> 7; \
        _Pragma("unroll") for (int it = 0; it < 3; ++it) { const int ch = tid + it * 512, r = ch >> 4, cc = ch & 15, tok = c_ * 64 - 16 + r; preg[it] = (u32x4){0u, 0u, 0u, 0u}; \
            if (ch < 1280 && tok >= 0) preg[it] = *(const u32x4*)(z + ((size_t)b_ * SEQ + tok) * ABW + 2048 + gi * 128 + cc * 8); } } while (0)
    int bc = vcu >> 2; const int step = G >> 2;
    if (bc < nbc) POOL_LOAD(bc);
    for (; bc < nbc; bc += step) {
        const int c = bc & 127, b = bc >> 7;
        const size_t row0 = (size_t)b * SEQ + c * 64;
#pragma unroll
        for (int it = 0; it < 3; ++it) { const int ch = tid + it * 512; if (ch < 1280) *(LAS u32x4*)(Ps + (ch >> 4) * PITCH + (ch & 15) * 16) = preg[it]; }
        __syncthreads();
        if (bc + step < nbc) POOL_LOAD(bc + step);
        {
            const int t = tid >> 3, cb = (tid & 7) * 32;
            float s[16];
#pragma unroll
            for (int e = 0; e < 16; ++e) s[e] = 0.f;
            for (int jj = 0; jj < wdw; ++jj) {
                const ldsp p = Ps + (16 + t - jj) * PITCH + cb;
                const u32x4 a = *(const LAS u32x4*)p, b2 = *(const LAS u32x4*)(p + 16);
                s[0] += bflo(a.x); s[1] += bfhi(a.x); s[2] += bflo(a.y); s[3] += bfhi(a.y); s[4] += bflo(a.z); s[5] += bfhi(a.z); s[6] += bflo(a.w); s[7] += bfhi(a.w);
                s[8] += bflo(b2.x); s[9] += bfhi(b2.x); s[10] += bflo(b2.y); s[11] += bfhi(b2.y); s[12] += bflo(b2.z); s[13] += bfhi(b2.z); s[14] += bflo(b2.w); s[15] += bfhi(b2.w);
            }
            const int cnt = min(c * 64 + t + 1, wdw); const float inv = 1.0f / (float)cnt;
            const ldsp p0 = Ps + (16 + t) * PITCH + cb;
            const u32x4 a = *(const LAS u32x4*)p0, b2 = *(const LAS u32x4*)(p0 + 16);
            u32x4 o0, o1;
            o0.x = pk2(s[0] * inv - bflo(a.x), s[1] * inv - bfhi(a.x)); o0.y = pk2(s[2] * inv - bflo(a.y), s[3] * inv - bfhi(a.y));
            o0.z = pk2(s[4] * inv - bflo(a.z), s[5] * inv - bfhi(a.z)); o0.w = pk2(s[6] * inv - bflo(a.w), s[7] * inv - bfhi(a.w));
            o1.x = pk2(s[8] * inv - bflo(b2.x), s[9] * inv - bfhi(b2.x)); o1.y = pk2(s[10] * inv - bflo(b2.y), s[11] * inv - bfhi(b2.y));
            o1.z = pk2(s[12] * inv - bflo(b2.z), s[13] * inv - bfhi(b2.z)); o1.w = pk2(s[14] * inv - bflo(b2.w), s[15] * inv - bfhi(b2.w));
            *(LAS u32x4*)(PO + t * PITCH + cb) = o0; *(LAS u32x4*)(PO + t * PITCH + cb + 16) = o1;
        }
        __syncthreads();
#pragma unroll
        for (int tt = 0; tt < 4; ++tt) {
            f32x4 acc = (f32x4){0.f, 0.f, 0.f, 0.f};
#pragma unroll
            for (int ks = 0; ks < 4; ++ks) { const bf16x8 bfr = lds_rd16(PO + (tt * 16 + i) * PITCH + (ks * 32 + g * 8) * 2); acc = MFMA16(af[ks], bfr, acc); }
            acc = acc * sc;
            u32x2 w; w.x = pk2(acc[0], acc[1]); w.y = pk2(acc[2], acc[3]);
            *(u32x2*)(CAT + (row0 + tt * 16 + i) * DM + 512 + gi * 128 + wave * 16 + g * 4) = w;
        }
        __syncthreads();
    }
#undef POOL_LOAD
}

__device__ __forceinline__ void retA_pool_phase(ldsp lds, const bf16* z, float* TS, const bf16* WpT, const float* scale, bf16* CAT, int vcu, int tid, int wave, int lane) {
    ldsp Kd = lds, Vs = lds + 64 * PITCH, Ps = lds + 128 * PITCH, PO = lds + 208 * PITCH;
    const int i = lane & 15, g = lane >> 4, lr = tid >> 4, lc = tid & 15;
    const int unit = vcu, bh = unit >> 3, seg = unit & 7, h = bh & 3;
    const float lg = head_lg(h), cd = EX2(64.0f * lg);
    const bf16* zb = z + ((size_t)(bh >> 2) * SEQ + (size_t)seg * 1024 + lr) * ABW + h * 128 + lc * 8;
    u32x4 kreg[2], vreg[2];
#define RA_LOAD(cc) do { _Pragma("unroll") for (int it = 0; it < 2; ++it) { const bf16* src = zb + ((size_t)(cc) * 64 + it * 32) * ABW; kreg[it] = *(const u32x4*)(src + 512); vreg[it] = *(const u32x4*)(src + 1024); } } while (0)
    const int gi = vcu & 3, wdw = 2 << gi;
    bf16x8 af[4];
#pragma unroll
    for (int ks = 0; ks < 4; ++ks) af[ks] = *(const bf16x8*)(WpT + (size_t)(gi * 128 + wave * 16 + i) * 128 + ks * 32 + g * 8);
    const f32x4 sc = *(const f32x4*)(scale + gi * 128 + wave * 16 + g * 4);
    u32x4 preg[3];
#define POOL_LOAD(bc) do { const int c_ = (bc) & 127, b_ = (bc) >> 7; \
        _Pragma("unroll") for (int it = 0; it < 3; ++it) { const int ch = tid + it * 512, r = ch >> 4, cc = ch & 15, tok = c_ * 64 - 16 + r; preg[it] = (u32x4){0u, 0u, 0u, 0u}; \
            if (ch < 1280 && tok >= 0) preg[it] = *(const u32x4*)(z + ((size_t)b_ * SEQ + tok) * ABW + 2048 + gi * 128 + cc * 8); } } while (0)
    RA_LOAD(0); POOL_LOAD(vcu >> 2);
    f32x4 st[8];
#pragma unroll
    for (int dt = 0; dt < 8; ++dt) st[dt] = (f32x4){0.f, 0.f, 0.f, 0.f};
    for (int k = 0; k < 16; ++k) {
        const int bc = (vcu >> 2) + 64 * k, c = bc & 127, b = bc >> 7;
        const size_t row0 = (size_t)b * SEQ + c * 64;
#pragma unroll
        for (int it = 0; it < 2; ++it) {
            const int r = lr + it * 32; const float dk = EX2((float)(63 - r) * lg);
            u32x4 kk = kreg[it];
            kk.x = pk2(bflo(kk.x) * dk, bfhi(kk.x) * dk); kk.y = pk2(bflo(kk.y) * dk, bfhi(kk.y) * dk); kk.z = pk2(bflo(kk.z) * dk, bfhi(kk.z) * dk); kk.w = pk2(bflo(kk.w) * dk, bfhi(kk.w) * dk);
            *(LAS u32x4*)(Kd + r * PITCH + lc * 16) = kk; *(LAS u32x4*)(Vs + r * PITCH + lc * 16) = vreg[it];
        }
#pragma unroll
        for (int it = 0; it < 3; ++it) { const int ch = tid + it * 512; if (ch < 1280) *(LAS u32x4*)(Ps + (ch >> 4) * PITCH + (ch & 15) * 16) = preg[it]; }
        __syncthreads();
        { const int kn = (k < 15) ? k + 1 : k; RA_LOAD(kn); POOL_LOAD((vcu >> 2) + 64 * kn); }
#pragma unroll
        for (int dt = 0; dt < 8; ++dt) st[dt] = st[dt] * cd;
        RET_KV_UPDATE(Kd, Vs);
        {
            const int t = tid >> 3, cb = (tid & 7) * 32;
            float s[16];
#pragma unroll
            for (int e = 0; e < 16; ++e) s[e] = 0.f;
            for (int jj = 0; jj < wdw; ++jj) {
                const ldsp p = Ps + (16 + t - jj) * PITCH + cb;
                const u32x4 a = *(const LAS u32x4*)p, b2 = *(const LAS u32x4*)(p + 16);
                s[0] += bflo(a.x); s[1] += bfhi(a.x); s[2] += bflo(a.y); s[3] += bfhi(a.y); s[4] += bflo(a.z); s[5] += bfhi(a.z); s[6] += bflo(a.w); s[7] += bfhi(a.w);
                s[8] += bflo(b2.x); s[9] += bfhi(b2.x); s[10] += bflo(b2.y); s[11] += bfhi(b2.y); s[12] += bflo(b2.z); s[13] += bfhi(b2.z); s[14] += bflo(b2.w); s[15] += bfhi(b2.w);
            }
            const int cnt = min(c * 64 + t + 1, wdw); const float inv = 1.0f / (float)cnt;
            const ldsp p0 = Ps + (16 + t) * PITCH + cb;
            const u32x4 a = *(const LAS u32x4*)p0, b2 = *(const LAS u32x4*)(p0 + 16);
            u32x4 o0, o1;
            o0.x = pk2(s[0] * inv - bflo(a.x), s[1] * inv - bfhi(a.x)); o0.y = pk2(s[2] * inv - bflo(a.y), s[3] * inv - bfhi(a.y));
            o0.z = pk2(s[4] * inv - bflo(a.z), s[5] * inv - bfhi(a.z)); o0.w = pk2(s[6] * inv - bflo(a.w), s[7] * inv - bfhi(a.w));
            o1.x = pk2(s[8] * inv - bflo(b2.x), s[9] * inv - bfhi(b2.x)); o1.y = pk2(s[10] * inv - bflo(b2.y), s[11] * inv - bfhi(b2.y));
            o1.z = pk2(s[12] * inv - bflo(b2.z), s[13] * inv - bfhi(b2.z)); o1.w = pk2(s[14] * inv - bflo(b2.w), s[15] * inv - bfhi(b2.w));
            *(LAS u32x4*)(PO + t * PITCH + cb) = o0; *(LAS u32x4*)(PO + t * PITCH + cb + 16) = o1;
        }
        __syncthreads();
#pragma unroll
        for (int tt = 0; tt < 4; ++tt) {
            f32x4 acc = (f32x4){0.f, 0.f, 0.f, 0.f};
#pragma unroll
            for (int ks = 0; ks < 4; ++ks) { const bf16x8 bfr = lds_rd16(PO + (tt * 16 + i) * PITCH + (ks * 32 + g * 8) * 2); acc = MFMA16(af[ks], bfr, acc); }
            acc = acc * sc;
            u32x2 w; w.x = pk2(acc[0], acc[1]); w.y = pk2(acc[2], acc[3]);
            *(u32x2*)(CAT + (row0 + tt * 16 + i) * DM + 512 + gi * 128 + wave * 16 + g * 4) = w;
        }
    }
    __syncthreads();
#undef RA_LOAD
#undef POOL_LOAD
    float* dst = TS + ((size_t)unit * 128 + wave * 16 + i) * 128 + g * 4;
#pragma unroll
    for (int dt = 0; dt < 8; ++dt) *(f32x4*)(dst + dt * 16) = st[dt];
}

__device__ __forceinline__ void retB_phase(ldsp lds, const bf16* z, const float* TS, const float* gn_gain, bf16* CAT, int vcu, int G, int tid, int wave, int lane) {
    ldsp Qs = lds, Ks = lds + 64 * PITCH, Vs = lds + 128 * PITCH, Kd = lds + 256 * PITCH, STs = lds + 320 * PITCH;
    const int i = lane & 15, g = lane >> 4, nt = wave & 3, eh = wave >> 2, lr = tid >> 4, lc = tid & 15;
    u32x4 qreg[2], kreg[2], vreg[2], greg[2];
    for (int unit = vcu; unit < 256; unit += G) {
        const int bh = unit >> 3, seg = unit & 7, b = bh >> 2, h = bh & 3;
        f32x4 gg[4];
#pragma unroll
        for (int et = 0; et < 4; ++et) gg[et] = *(const f32x4*)(gn_gain + h * 128 + eh * 64 + et * 16 + g * 4);
        const float lg = head_lg(h), cd = EX2(64.0f * lg);
        const bf16* zb = z + ((size_t)b * SEQ + (size_t)seg * 1024 + lr) * ABW + h * 128 + lc * 8;
#define RB_LOAD(cc) do { _Pragma("unroll") for (int it = 0; it < 2; ++it) { const bf16* src = zb + ((size_t)(cc) * 64 + it * 32) * ABW; \
            qreg[it] = *(const u32x4*)src; kreg[it] = *(const u32x4*)(src + 512); vreg[it] = *(const u32x4*)(src + 1024); greg[it] = *(const u32x4*)(src + 1536); } } while (0)
        RB_LOAD(0);
        f32x4 st[8];
#pragma unroll
        for (int dt = 0; dt < 8; ++dt) st[dt] = (f32x4){0.f, 0.f, 0.f, 0.f};
        for (int sp = 0; sp < seg; ++sp) {
            const float wsp = EX2(1024.0f * lg * (float)(seg - 1 - sp));
            const float* src = TS + ((size_t)(bh * 8 + sp) * 128 + wave * 16 + i) * 128 + g * 4;
#pragma unroll
            for (int dt = 0; dt < 8; ++dt) st[dt] = st[dt] + *(const f32x4*)(src + dt * 16) * wsp;
        }
        for (int cc = 0; cc < 16; ++cc) {
            const size_t row0 = (size_t)b * SEQ + (size_t)(seg * 16 + cc) * 64;
            const ldsp Gs = (cc & 1) ? lds + 448 * PITCH : lds + 192 * PITCH;
            LAS float* RED = (LAS float*)(lds + 512 * PITCH) + (cc & 1) * 256;
#pragma unroll
            for (int it = 0; it < 2; ++it) { const int r = lr + it * 32, off = r * PITCH + lc * 16; const float dk = EX2((float)(63 - r) * lg);
                u32x4 kk = kreg[it];
                kk.x = pk2(bflo(kk.x) * dk, bfhi(kk.x) * dk); kk.y = pk2(bflo(kk.y) * dk, bfhi(kk.y) * dk); kk.z = pk2(bflo(kk.z) * dk, bfhi(kk.z) * dk); kk.w = pk2(bflo(kk.w) * dk, bfhi(kk.w) * dk);
                *(LAS u32x4*)(Qs + off) = qreg[it]; *(LAS u32x4*)(Ks + off) = kreg[it]; *(LAS u32x4*)(Vs + off) = vreg[it]; *(LAS u32x4*)(Gs + off) = greg[it]; *(LAS u32x4*)(Kd + off) = kk; }
#pragma unroll
            for (int dt = 0; dt < 8; ++dt) { u32x2 w; w.x = pk2(st[dt][0], st[dt][1]); w.y = pk2(st[dt][2], st[dt][3]); *(LAS u32x2*)(STs + (wave * 16 + i) * PITCH + (dt * 16 + g * 4) * 2) = w; }
            __syncthreads();
            RB_LOAD(cc < 15 ? cc + 1 : cc);
            bf16x8 qf[4];
#pragma unroll
            for (int ks = 0; ks < 4; ++ks) qf[ks] = lds_rd16(Qs + (nt * 16 + i) * PITCH + (ks * 32 + g * 8) * 2);
            f32x4 sT[4];
#pragma unroll
            for (int mt = 0; mt < 4; ++mt) { sT[mt] = (f32x4){0.f, 0.f, 0.f, 0.f};
#pragma unroll
                for (int ks = 0; ks < 4; ++ks) { const bf16x8 kf = lds_rd16(Ks + (mt * 16 + i) * PITCH + (ks * 32 + g * 8) * 2); sT[mt] = MFMA16(kf, qf[ks], sT[mt]); } }
            const int n = nt * 16 + i;
#pragma unroll
            for (int mt = 0; mt < 4; ++mt)
#pragma unroll
                for (int j = 0; j < 4; ++j) { const int m = mt * 16 + g * 4 + j; sT[mt][j] *= EX2(fabsf((float)(n - m)) * lg); }
            bf16x8 Pf[2]; Pf[0] = pack8(sT[0], sT[1]); Pf[1] = pack8(sT[2], sT[3]);
            f32x4 o[4];
            const float qd = EX2((float)(n + 1) * lg);
#pragma unroll
            for (int et = 0; et < 4; ++et) { o[et] = (f32x4){0.f, 0.f, 0.f, 0.f}; const int e0 = (eh * 4 + et) * 16;
#pragma unroll
                for (int ks = 0; ks < 4; ++ks) { const bf16x8 sf = lds_rd16(STs + (e0 + i) * PITCH + (ks * 32 + g * 8) * 2); o[et] = MFMA16(sf, qf[ks], o[et]); }
                o[et] = o[et] * qd; }
#pragma unroll
            for (int ks2 = 0; ks2 < 2; ++ks2)
#pragma unroll
                for (int et = 0; et < 4; ++et) { const int e0 = (eh * 4 + et) * 16;
                    const bf16x8 vf = trfrag(Vs + (ks2 * 32 + g * 4 + (i >> 2)) * PITCH + (e0 + 4 * (i & 3)) * 2, 16 * PITCH); o[et] = MFMA16(vf, Pf[ks2], o[et]); }
#pragma unroll
            for (int dt = 0; dt < 8; ++dt) st[dt] = st[dt] * cd;
            RET_KV_UPDATE(Kd, Vs);
            float a1 = 0.f, a2 = 0.f;
#pragma unroll
            for (int et = 0; et < 4; ++et)
#pragma unroll
                for (int j = 0; j < 4; ++j) { a1 += o[et][j]; a2 += o[et][j] * o[et][j]; }
            a1 = xrow_sum(a1); a2 = xrow_sum(a2);
            if (g == 0) { RED[(wave * 16 + i) * 2] = a1; RED[(wave * 16 + i) * 2 + 1] = a2; }
            __syncthreads();
            {
                const float pa = RED[((wave ^ 4) * 16 + i) * 2], pq = RED[((wave ^ 4) * 16 + i) * 2 + 1];
                const float mean = (a1 + pa) * (1.0f / 128.0f), var = fmaxf((a2 + pq) * (1.0f / 128.0f) - mean * mean, 0.f), rstd = rsqrtf(var + GN_EPS);
                const size_t row = row0 + n;
#pragma unroll
                for (int et = 0; et < 4; ++et) { const int e = eh * 64 + et * 16 + g * 4;
                    const u32x2 gw = *(const LAS u32x2*)(Gs + n * PITCH + e * 2);
                    const float g0 = bflo(gw.x), g1 = bfhi(gw.x), g2 = bflo(gw.y), g3 = bfhi(gw.y);
                    const float y0 = (o[et][0] - mean) * rstd * gg[et][0] * (g0 / (1.0f + __expf(-g0)));
                    const float y1 = (o[et][1] - mean) * rstd * gg[et][1] * (g1 / (1.0f + __expf(-g1)));
                    const float y2 = (o[et][2] - mean) * rstd * gg[et][2] * (g2 / (1.0f + __expf(-g2)));
                    const float y3 = (o[et][3] - mean) * rstd * gg[et][3] * (g3 / (1.0f + __expf(-g3)));
                    u32x2 w; w.x = pk2(y0, y1); w.y = pk2(y2, y3);
                    *(u32x2*)(CAT + row * DM + h * 128 + e) = w; }
            }
        }
        __syncthreads();
#undef RB_LOAD
    }
}

constexpr int KPITCH = 144, VPITCH = 160;
constexpr int ATT_BUF = 64 * KPITCH + 64 * VPITCH;
__device__ __forceinline__ void attn_phase(ldsp lds, const bf16* qkv, const float* relb, bf16* O, int vcu, int G, int tid, int wave, int lane) {
    const int head = vcu & 15;
    LAS float* BH = (LAS float*)(lds + 4 * ATT_BUF);
    for (int t2 = tid; t2 < 257; t2 += NTHR) BH[t2] = relb[head * 257 + t2] * LOG2E;
    const int i = lane & 15, g = lane >> 4, cw = wave >> 1, qh = wave & 1;
    const int lr = tid >> 3, lc = tid & 7;
    u32x4 kA, vA, kB, vB;
#define ATT_B(u_) (((u_) & 255) >> 5)
#define ATT_C0(u_) ((((u_) >> 8) * 2 + ((((u_) & 255) >> 4) & 1)) * 4)
#define ATT_T0(c0_) (((c0_) < 8) ? 0 : (c0_) - 8)
#define ATT_LOAD(KR, VR) do { const bf16* src = qkv + ((size_t)ATT_B(ul) * SEQ + (size_t)Tl * 64 + lr) * QKVW + DM + head * 64 + lc * 8; KR = *(const u32x4*)src; VR = *(const u32x4*)(src + DM); \
        if (Tl == ATT_C0(ul) + 3) { if (ul + G < 4096) { ul += G; Tl = ATT_T0(ATT_C0(ul)); } } else ++Tl; } while (0)
#define ATT_QLOAD(dst, b_, c_) do { const size_t qr_ = (size_t)(b_) * SEQ + (c_) * 64 + qh * 32 + i; \
        _Pragma("unroll") for (int qa = 0; qa < 2; ++qa) _Pragma("unroll") for (int ks = 0; ks < 2; ++ks) dst[qa][ks] = *(const bf16x8*)(qkv + (qr_ + qa * 16) * QKVW + head * 64 + ks * 32 + g * 8); } while (0)
    int u = vcu, par = 0;
    int ul = vcu, Tl = ATT_T0(ATT_C0(vcu));
    bf16x8 qf[2][2], qn[2][2];
    ATT_LOAD(kA, vA); ATT_LOAD(kB, vB);
    if (u < 4096) ATT_QLOAD(qf, ATT_B(u), ATT_C0(u) + cw);
    for (; u < 4096; u += G) {
        const int b = ATT_B(u), c0 = ATT_C0(u);
        const int c = c0 + cw;
        const int T0 = ATT_T0(c0), T1 = c0 + 3;
        const bool has_next = (u + G < 4096);
        float m_i[2] = {0.f, 0.f}, l_i[2] = {0.f, 0.f};
        const int tfirst = (c < 8) ? 8 - c : 0;
        f32x4 acc[2][4];
#pragma unroll
        for (int qa = 0; qa < 2; ++qa)
#pragma unroll
            for (int dt = 0; dt < 4; ++dt) acc[qa][dt] = (f32x4){0.f, 0.f, 0.f, 0.f};
#define ATT_STEP(Kt, T) do { \
            const ldsp Vt = (Kt) + 64 * KPITCH; \
            const int t = (T) - (c - 8);                            \
            if (t >= 0 && t <= 8) { \
                const float cb = (t <= 5) ? BH[256] : 0.f;          \
                f32x4 sT[2][4]; \
                const float i0 = cb - m_i[0], i1 = cb - m_i[1]; \
                _Pragma("unroll") for (int kt = 0; kt < 4; ++kt) { sT[0][kt] = (f32x4){i0, i0, i0, i0}; sT[1][kt] = (f32x4){i1, i1, i1, i1}; \
                    _Pragma("unroll") for (int ks = 0; ks < 2; ++ks) { const bf16x8 kf = lds_rd16(Kt + (kt * 16 + i) * KPITCH + (ks * 32 + g * 8) * 2); \
                        sT[0][kt] = MFMA16(kf, qf[0][ks], sT[0][kt]); sT[1][kt] = MFMA16(kf, qf[1][ks], sT[1][kt]); } } \
                if (t > 5) { \
                    _Pragma("unroll") for (int qa = 0; qa < 2; ++qa) { const int base = (qh * 32 + qa * 16 + i) + 640 - t * 64 - g * 4; \
                        _Pragma("unroll") for (int kt = 0; kt < 4; ++kt) \
                            _Pragma("unroll") for (int j = 0; j < 4; ++j) sT[qa][kt][j] += BH[min(base - kt * 16 - j, 256)]; } \
                } \
                bf16x8 Pb[2][2]; \
                _Pragma("unroll") for (int qa = 0; qa < 2; ++qa) { \
                    float mx = fmaxf(fmaxf(sT[qa][0][0], sT[qa][0][1]), fmaxf(sT[qa][0][2], sT[qa][0][3])); \
                    _Pragma("unroll") for (int kt = 1; kt < 4; ++kt) mx = fmaxf(mx, fmaxf(fmaxf(sT[qa][kt][0], sT[qa][kt][1]), fmaxf(sT[qa][kt][2], sT[qa][kt][3]))); \
                    mx = xrow_max(mx);                              \
                    if (t == tfirst || __any(mx > 8.0f)) {          \
                        const float dl = (t == tfirst) ? mx : fmaxf(mx, 0.f), alpha = (t == tfirst) ? 1.0f : EX2(-dl); m_i[qa] += dl;     \
                        _Pragma("unroll") for (int kt = 0; kt < 4; ++kt) sT[qa][kt] = sT[qa][kt] - dl; \
                        l_i[qa] *= alpha; \
                        _Pragma("unroll") for (int dt = 0; dt < 4; ++dt) acc[qa][dt] = acc[qa][dt] * alpha; \
                    } \
                    float rs = 0.f; \
                    _Pragma("unroll") for (int kt = 0; kt < 4; ++kt) \
                        _Pragma("unroll") for (int j = 0; j < 4; ++j) { const float p = EX2(sT[qa][kt][j]); sT[qa][kt][j] = p; rs += p; } \
                    l_i[qa] += rs; \
                    Pb[qa][0] = pack8(sT[qa][0], sT[qa][1]); Pb[qa][1] = pack8(sT[qa][2], sT[qa][3]); \
                } \
                _Pragma("unroll") for (int ks2 = 0; ks2 < 2; ++ks2) \
                    _Pragma("unroll") for (int dt = 0; dt < 4; ++dt) { const bf16x8 vf = trfrag(Vt + (ks2 * 32 + g * 4 + (i >> 2)) * VPITCH + (dt * 16 + 4 * (i & 3)) * 2, 16 * VPITCH); \
                        acc[0][dt] = MFMA16(vf, Pb[0][ks2], acc[0][dt]); acc[1][dt] = MFMA16(vf, Pb[1][ks2], acc[1][dt]); } \
            } } while (0)
        { const int un = has_next ? u + G : u; ATT_QLOAD(qn, ATT_B(un), ATT_C0(un) + cw); }
        for (int T = T0; T <= T1; T += 2) {
            const ldsp K0 = lds + (2 * par) * ATT_BUF, K1 = K0 + ATT_BUF; par ^= 1;
            *(LAS u32x4*)(K0 + lr * KPITCH + lc * 16) = kA; *(LAS u32x4*)(K0 + 64 * KPITCH + lr * VPITCH + lc * 16) = vA;
            *(LAS u32x4*)(K1 + lr * KPITCH + lc * 16) = kB; *(LAS u32x4*)(K1 + 64 * KPITCH + lr * VPITCH + lc * 16) = vB;
            __syncthreads();
            ATT_LOAD(kA, vA); ATT_LOAD(kB, vB);
            ATT_STEP(K0, T); ATT_STEP(K1, T + 1);
        }
#undef ATT_STEP
        const size_t qrow0 = (size_t)b * SEQ + c * 64 + qh * 32 + i;
#pragma unroll
        for (int qa = 0; qa < 2; ++qa) {
            const float inv = 1.0f / xrow_sum(l_i[qa]);
#pragma unroll
            for (int dt = 0; dt < 4; ++dt) { u32x2 w; w.x = pk2(acc[qa][dt][0] * inv, acc[qa][dt][1] * inv); w.y = pk2(acc[qa][dt][2] * inv, acc[qa][dt][3] * inv);
                *(u32x2*)(O + (qrow0 + qa * 16) * DM + head * 64 + dt * 16 + g * 4) = w; }
        }
#pragma unroll
        for (int qa = 0; qa < 2; ++qa)
#pragma unroll
            for (int ks = 0; ks < 2; ++ks) qf[qa][ks] = qn[qa][ks];
    }
    __syncthreads();
#undef ATT_LOAD
#undef ATT_QLOAD
#undef ATT_B
#undef ATT_C0
#undef ATT_T0
}

#define XB_TMO      128
#define XB_XCNT(j)  (256  + 64 * (j))
#define XB_XSUB(j)  (1280 + 64 * (j))
#define XB_XGEN(j)  (2304 + 64 * (j))
#define XB_TOP      3328
#define XB_TOPGEN   3392
#define XCD_BAR_WORDS 3456
#define XB_SPIN_CAP (1u << 18)

__device__ __forceinline__ unsigned xb_ld(unsigned* p)              { return __hip_atomic_load(p, __ATOMIC_RELAXED, __HIP_MEMORY_SCOPE_AGENT); }
__device__ __forceinline__ unsigned xb_add(unsigned* p, unsigned v) { return __hip_atomic_fetch_add(p, v, __ATOMIC_RELAXED, __HIP_MEMORY_SCOPE_AGENT); }
__device__ __forceinline__ unsigned xb_xcc_id() { return (unsigned)__builtin_amdgcn_s_getreg((3 << 11) | 20) & 0xFu; }
#define XB_SPIN(cond, bar) do { unsigned _sp = 0; while (cond) { __builtin_amdgcn_s_sleep(1); \
    if ((++_sp & 255u) == 0u) { if (xb_ld(&(bar)[XB_TMO])) break; if (_sp > XB_SPIN_CAP) { atomicAdd(&(bar)[XB_TMO], 1u); break; } } } } while (0)

struct XcdBarrier {
    unsigned* bar; unsigned x;
    volatile LAS unsigned* st;
};

__device__ __forceinline__ XcdBarrier xcd_barrier_post(unsigned* bar, volatile LAS unsigned* st) {
    XcdBarrier b; b.bar = bar; b.x = xb_xcc_id(); b.st = st;
    if (threadIdx.x == 0) (void)xb_add(&bar[XB_XCNT(b.x)], 1u);
    return b;
}
__device__ __forceinline__ void xcd_barrier_complete(unsigned* bar, unsigned x, unsigned& nloc, unsigned& nx) {
    const unsigned G = gridDim.x * gridDim.y * gridDim.z;
    unsigned sum, cnt, mine, sp = 0u;
    for (;;) {
        sum = 0u; cnt = 0u; mine = 0u;
#pragma unroll
        for (unsigned j = 0; j < 16; ++j) { const unsigned c = xb_ld(&bar[XB_XCNT(j)]); sum += c; cnt += (c > 0u) ? 1u : 0u; mine = (j == x) ? c : mine; }
        if (sum == G) break;
        __builtin_amdgcn_s_sleep(1);
        if ((++sp & 255u) == 0u) { if (xb_ld(&bar[XB_TMO])) break; if (sp > XB_SPIN_CAP) { atomicAdd(&bar[XB_TMO], 1u); break; } }
    }
    nloc = mine > 0u ? mine : 1u; nx = cnt > 0u ? cnt : 1u;
}

__device__ __forceinline__ void xcd_barrier(const XcdBarrier& b) {
    asm volatile("s_waitcnt vmcnt(0)" ::: "memory");
    __syncthreads();
    if (threadIdx.x == 0) {
        unsigned* bar = b.bar;
        __builtin_amdgcn_s_waitcnt(0);
        unsigned nloc = b.st[0], nx = b.st[1];
        if (nloc == 0u) { xcd_barrier_complete(bar, b.x, nloc, nx); b.st[0] = nloc; b.st[1] = nx; }
        const unsigned old = xb_add(&bar[XB_XSUB(b.x)], 1u);
        const unsigned gen = old / nloc;
        if (old + 1u == (gen + 1u) * nloc) {
            __builtin_amdgcn_fence(__ATOMIC_RELEASE, "agent");
            asm volatile("s_waitcnt vmcnt(0)" ::: "memory");
            const unsigned og = xb_add(&bar[XB_TOP], 1u);
            const unsigned tg = og / nx;
            if (og + 1u == (tg + 1u) * nx) xb_add(&bar[XB_TOPGEN], 1u);
            else XB_SPIN(xb_ld(&bar[XB_TOPGEN]) == tg, bar);
            __builtin_amdgcn_fence(__ATOMIC_ACQUIRE, "agent");
            xb_add(&bar[XB_XGEN(b.x)], 1u);
            asm volatile("s_waitcnt vmcnt(0)" ::: "memory");
        } else {
            XB_SPIN(xb_ld(&bar[XB_XGEN(b.x)]) == gen, bar);
            __builtin_amdgcn_fence(__ATOMIC_ACQUIRE, "agent");
            asm volatile("s_waitcnt vmcnt(0)" ::: "memory");
        }
    }
    __syncthreads();
}

__global__ void __launch_bounds__(NTHR, 2) fwd_megakernel(Params P) {
    extern __shared__ __attribute__((aligned(16))) unsigned char lds_raw[];
    const ldsp lds = (ldsp)lds_raw;
    cg::grid_group grid = cg::this_grid();
    const int tid0 = threadIdx.x;
    const int G = gridDim.x, bx = blockIdx.x;
    const int vcu = (G % 8 == 0) ? (bx % 8) * (G / 8) + bx / 8 : bx;
    unsigned char* ws = P.ws;
    float* ssq = (float*)(ws + WS_SSQ);
    const float* rot = (const float*)(ws + WS_ROT);
    bf16* Wb = (bf16*)(ws + WS_W);
    bf16* XB = (bf16*)(ws + WS_XB);
    float* TS = (float*)(ws + WS_KV);
    bf16* BIG = (bf16*)(ws + WS_BIG);
    bf16* Z = BIG; bf16* CAT = BIG + (size_t)MTOK * ABW;
    bf16* QKV = BIG; bf16* OB = BIG + (size_t)MTOK * QKVW;
    bf16* HB = BIG;
    const int lo = P.ph_lo, hi = P.ph_hi;
    int ph = 0;
    volatile LAS unsigned* BST = (volatile LAS unsigned*)(lds + LDS_BYTES - 64);
    if (tid0 == 0) { BST[0] = 0u; BST[1] = 0u; }
    __syncthreads();
    unsigned* barw = (unsigned*)ws;
    XcdBarrier xbar; xbar.bar = barw; xbar.x = 0; xbar.st = BST;
#ifndef PH_MASK
#define PH_MASK 0xffff
#endif
#ifndef DUP_MASK
#define DUP_MASK 0
#endif
#define PHASE_BEGIN_K(k) if (((PH_MASK >> (k)) & 1) && ph >= lo && ph < hi) { for (int rep_ = 0; rep_ < (((DUP_MASK >> (k)) & 1) ? 2 : 1); ++rep_) { int tid = tid0; asm volatile("" : "+v"(tid)); const int lane = tid & 63, wave = __builtin_amdgcn_readfirstlane(tid >> 6); (void)lane; (void)wave;
#define PHASE_END   if (ph + 1 < hi) { if (ph == 0) { asm volatile("s_waitcnt vmcnt(0) lgkmcnt(0)" ::: "memory"); grid.sync(); __builtin_amdgcn_fence(__ATOMIC_ACQUIRE, "agent"); asm volatile("s_waitcnt vmcnt(0)" ::: "memory"); \
            xbar = xcd_barrier_post(barw, BST); } else xcd_barrier(xbar); } } } ++ph;

    PHASE_BEGIN_K(0) if (bx == 0) { for (int k_ = tid; k_ < 4096; k_ += NTHR) barw[k_] = 0u; } prologue(P, lds, tid, wave, lane, vcu, G); PHASE_END

    for (int L = 0; L < DEPTH; ++L) {
        const int li = L >> 1;
        if ((L & 1) == 0) {
            const bf16* Wint = Wb + (W_EVEN + (size_t)li * 8 * MiB) / 2; const bf16* Woutt = Wint + (5 * MiB) / 2; const bf16* WpT = Wint + (7 * MiB) / 2;
            PHASE_BEGIN_K(1)
                pg8::Gemm g{XB, Wint, MTOK, ABW, DM}; pg8::StaticOrder S; S.init(MTOK, ABW, G, bx);
                EpiProj<0> E{Z, ABW, ssq, rot};
                pg8::gemm_phase<EpiProj<0>, pg8::StaticOrder, true, true>(lds, g, S, E);
            PHASE_END
            PHASE_BEGIN_K(2)
                if (G == 256) retA_pool_phase(lds, Z, TS, WpT, P.ab_pool_scale + li * 512, CAT, vcu, tid, wave, lane);
                else { retA_phase(lds, Z, TS, vcu, G, tid, wave, lane); pool_phase(lds, Z, WpT, P.ab_pool_scale + li * 512, CAT, vcu, G, tid, wave, lane); }
            PHASE_END
            PHASE_BEGIN_K(4)
                retB_phase(lds, Z, TS, P.ab_gn_gain + li * 512, CAT, vcu, G, tid, wave, lane);
            PHASE_END
            PHASE_BEGIN_K(5)
                pg8::Gemm g{CAT, Woutt, MTOK, DM, DM}; pg8::StaticOrder S; S.init(MTOK, DM, G, bx);
                EpiRes E{(L == 0) ? P.x : (const float*)nullptr, (float*)nullptr, XB, ssq + (size_t)MTOK * 16, (const float*)nullptr};
                pg8::gemm_phase<EpiRes, pg8::StaticOrder, true, true>(lds, g, S, E);
            PHASE_END
        } else {
            const bf16* Wqkvt = Wb + (W_ODD + (size_t)li * 8 * MiB) / 2; const bf16* Wot = Wqkvt + (6 * MiB) / 2;
            PHASE_BEGIN_K(6)
                pg8::Gemm g{XB, Wqkvt, MTOK, QKVW, DM}; pg8::StaticOrder S; S.init(MTOK, QKVW, G, bx);
                EpiProj<2> E{QKV, QKVW, ssq, rot};
                pg8::gemm_phase<EpiProj<2>, pg8::StaticOrder, true, true>(lds, g, S, E);
            PHASE_END
            PHASE_BEGIN_K(7)
                attn_phase(lds, QKV, P.c_rel_bias + li * 16 * 257, OB, vcu, G, tid, wave, lane);
            PHASE_END
            PHASE_BEGIN_K(8)
                pg8::Gemm g{OB, Wot, MTOK, DM, DM}; pg8::StaticOrder S; S.init(MTOK, DM, G, bx);
                EpiRes E{(L == 0) ? P.x : (const float*)nullptr, (float*)nullptr, XB, ssq + (size_t)MTOK * 16, (const float*)nullptr};
                pg8::gemm_phase<EpiRes, pg8::StaticOrder, true, true>(lds, g, S, E);
            PHASE_END
        }
        const bf16* W1t = Wb + (W_FFN + (size_t)L * 16 * MiB) / 2; const bf16* W2t = W1t + (8 * MiB) / 2;
        PHASE_BEGIN_K(9)
            pg8::Gemm g{XB, W1t, MTOK, FF, DM}; pg8::StaticOrder S; S.init(MTOK, FF, G, bx);
            EpiProj<1> E{HB, FF, ssq + (size_t)MTOK * 16, rot};
            pg8::gemm_phase<EpiProj<1>, pg8::StaticOrder, true, true>(lds, g, S, E);
        PHASE_END
        PHASE_BEGIN_K(10)
            pg8::Gemm g{HB, W2t, MTOK, DM, FF}; pg8::StaticOrder S; S.init(MTOK, DM, G, bx);
            EpiRes E{(const float*)nullptr, (L == DEPTH - 1) ? P.out : (float*)nullptr, XB, ssq, ssq + (size_t)MTOK * 16};
            pg8::gemm_phase<EpiRes, pg8::StaticOrder, true, true, true>(lds, g, S, E);
        PHASE_END
    }
    PHASE_BEGIN_K(11)
        const int gw = vcu * NWAVES + wave, NGW = G * NWAVES;
        const f32x4* gr = (const f32x4*)P.final_norm + lane;
        f32x4 gv[4];
#pragma unroll
        for (int j = 0; j < 4; ++j) gv[j] = gr[64 * j];
        for (int m0 = gw * 4; m0 < MTOK; m0 += NGW * 4) {
            f32x4 v[4][4]; float rs[4];
#pragma unroll
            for (int r = 0; r < 4; ++r) { const f32x4* xr = (const f32x4*)(P.out + (size_t)(m0 + r) * DM) + lane; rs[r] = row_rstd(ssq, (size_t)(m0 + r));
#pragma unroll
                for (int j = 0; j < 4; ++j) v[r][j] = xr[64 * j]; }
#pragma unroll
            for (int r = 0; r < 4; ++r) { f32x4* xo = (f32x4*)(P.out + (size_t)(m0 + r) * DM) + lane;
#pragma unroll
                for (int j = 0; j < 4; ++j) xo[64 * j] = v[r][j] * rs[r] * gv[j]; }
        }
    PHASE_END
#undef PHASE_BEGIN_K
#undef PHASE_END
}

extern "C" void kernel_launch(void* const* d_in, const int* in_sizes, int n_in, void* d_out, int out_size, void* d_ws, size_t ws_size, hipStream_t stream) {
    static int grid = 0;
    if (grid == 0) {
        if (n_in != 14 || in_sizes[0] != MTOK * DM || out_size != MTOK * DM || ws_size < WS_END) {
            fprintf(stderr, "kernel_launch: unexpected shapes/workspace: n_in %d in0 %d out %d ws %zu (need %zu)\n", n_in, n_in > 0 ? in_sizes[0] : -1, out_size, ws_size, (size_t)WS_END); grid = -1; return; }
        int dev = 0, cus = 0, per_cu = 0;
        if (hipGetDevice(&dev) != hipSuccess || hipDeviceGetAttribute(&cus, hipDeviceAttributeMultiprocessorCount, dev) != hipSuccess) { grid = -1; return; }
        if (hipFuncSetAttribute((const void*)fwd_megakernel, hipFuncAttributeMaxDynamicSharedMemorySize, LDS_BYTES) != hipSuccess) { fprintf(stderr, "kernel_launch: hipFuncSetAttribute failed\n"); grid = -1; return; }
        if (hipOccupancyMaxActiveBlocksPerMultiprocessor(&per_cu, (const void*)fwd_megakernel, NTHR, LDS_BYTES) != hipSuccess || per_cu < 1) { fprintf(stderr, "kernel_launch: occupancy query says %d\n", per_cu); per_cu = 1; }
        (void)hipGetLastError();
        grid = cus;
    }
    if (grid < 0) return;
    Params p{};
    p.x = (const float*)d_in[0]; p.mix_norm = (const float*)d_in[1]; p.ffn_norm = (const float*)d_in[2]; p.w_ffn_in = (const float*)d_in[3]; p.w_ffn_out = (const float*)d_in[4];
    p.ab_w_in = (const float*)d_in[5]; p.ab_gn_gain = (const float*)d_in[6]; p.ab_w_pool = (const float*)d_in[7]; p.ab_pool_scale = (const float*)d_in[8]; p.ab_w_out = (const float*)d_in[9];
    p.c_w_qkv = (const float*)d_in[10]; p.c_rel_bias = (const float*)d_in[11]; p.c_w_out = (const float*)d_in[12]; p.final_norm = (const float*)d_in[13];
    p.out = (float*)d_out; p.ws = (unsigned char*)d_ws; p.ph_lo = 0; p.ph_hi = 1 << 20;
    void* args[] = {&p};
    const hipError_t e = hipLaunchCooperativeKernel((const void*)fwd_megakernel, dim3(grid), dim3(NTHR), args, LDS_BYTES, stream);
    if (e != hipSuccess) fprintf(stderr, "kernel_launch: cooperative launch failed: %s (grid %d)\n", hipGetErrorString(e), grid);
}
```

```cpp
#include <hip/hip_runtime.h>
#include <hip/hip_cooperative_groups.h>
#include <cstdio>
#include <cstdint>
#include <cmath>
namespace cg = cooperative_groups;
namespace pg8 {
#define PG8_LAS __attribute__((address_space(3)))
typedef unsigned short bf16_t;
typedef short bf16x8 __attribute__((ext_vector_type(8)));
typedef float f32x4 __attribute__((ext_vector_type(4)));
typedef unsigned u32x4 __attribute__((ext_vector_type(4)));
constexpr int BM = 256, BK = 64, HALF = 128, HTB = HALF * BK * 2  , STAGE_BYTES = 8 * HTB, NXCD = 8, WGM = 8;

__host__ __device__ __forceinline__ int lds_byte(int r, int c) { const int st = (r >> 4) * 2 + (c >> 5), rr = r & 15, cc = c & 31, ob = rr * 64 + cc * 2; return st * 1024 + (ob ^ (((ob >> 9) & 1) << 5)); }
__host__ __device__ __forceinline__ void stage_rc(int b, int& R, int& C) { const int st = b / 1024, sb = b % 1024, swz = sb ^ (((sb >> 9) & 1) << 5); R = (st >> 1) * 16 + swz / 64; C = (st & 1) * 32 + (swz % 64) / 2; }
__host__ __device__ __forceinline__ int perm32(int rho) { const int n = rho >> 4, i = rho & 15; return 8 * (i >> 2) + 4 * n + (i & 3); }

struct Unit { int pm, pn; };
struct Gemm { const bf16_t* A; const bf16_t* Bt; int M, N, K; };

struct StaticOrder {
    int nM, nN, nwg, G, c;
    __host__ __device__ void init(int M, int N, int G_, int c_) { nM = M / BM; nN = N / BM; nwg = nM * nN; G = G_; c = c_; }
    __host__ __device__ bool next(int i, Unit& u) const {
        const long L = (long)i * G + c; if (L >= nwg) return false;
        int wgid = (int)L; { const int q = nwg / NXCD, r = nwg % NXCD, xcd = wgid % NXCD, off = wgid / NXCD; wgid = (xcd < r ? xcd * (q + 1) : r * (q + 1) + (xcd - r) * q) + off; }
        const int nig = WGM * nN, gid = wgid / nig, fm = gid * WGM, gsz = (nM - fm) < WGM ? (nM - fm) : WGM;
        u.pm = fm + ((wgid % nig) % gsz); u.pn = (wgid % nig) / gsz; return true;
    }
    __device__ __forceinline__ void a_ready(const Unit&) const {}
    __device__ __forceinline__ void done(const Unit&) const {}
};

template <class Epi, class Sched, bool ALIGN_EPI = false, bool SP2 = false, bool A_TILED = false>
__device__ __forceinline__ void gemm_phase(PG8_LAS unsigned char* lds, const Gemm g, const Sched& S, const Epi& E) {
    int tid = threadIdx.x; asm volatile("" : "+v"(tid));
    const int wid = __builtin_amdgcn_readfirstlane(tid >> 6), lane = tid & 63, wr = wid >> 2, wc = wid & 3, fr = lane & 15, fq = lane >> 4;
    const int K = g.K, nt = K / BK;
    unsigned voffA[2], voffB[2];
#pragma unroll
    for (int i = 0; i < 2; ++i) { int R, C; stage_rc(tid * 16 + i * 8192, R, C); const int Rb = Epi::PERM ? ((R & ~31) + perm32(R & 31)) : R;
        voffA[i] = A_TILED ? (unsigned)(((R >> 4) * (K >> 5) + (C >> 5)) * 1024 + ((R & 15) * 32 + (C & 31)) * 2) : (unsigned)(R * K + C) * 2u; voffB[i] = (unsigned)(Rb * K + C) * 2u; }
    const size_t kstep = (size_t)(BK * 2);
    const size_t kstepA = A_TILED ? (size_t)2048 : kstep;
    const size_t hstep = (size_t)HALF * K * 2;
    const size_t tstep = 2 * hstep;
    const unsigned ldsw = (unsigned)wid * 1024u;
    const int aoff = lds_byte(wr * 64 + fr, fq * 8), boff = lds_byte(wc * 32 + fr, fq * 8);
#define PG8_SA(b, h) (((b) * 2 + (h)) * HTB)
#define PG8_SB(b, h) ((4 + (b) * 2 + (h)) * HTB)
#define PG8_STAGE(bufoff, gbase, voff) do { _Pragma("unroll") for (int _i = 0; _i < 2; ++_i) \
        __builtin_amdgcn_global_load_lds((const unsigned*)((const char*)(gbase) + (voff)[_i]), (PG8_LAS unsigned*)(lds + (bufoff) + ldsw + _i * 8192), 16, 0, 0); } while (0)
#define PG8_LDA(dst, b, h) do { _Pragma("unroll") for (int m = 0; m < 4; ++m) _Pragma("unroll") for (int k = 0; k < 2; ++k) dst[m][k] = *(const PG8_LAS bf16x8*)(lds + PG8_SA(b, h) + aoff + m * 2048 + k * 1024); } while (0)
#define PG8_LDB(dst, b, h) do { _Pragma("unroll") for (int n = 0; n < 2; ++n) _Pragma("unroll") for (int k = 0; k < 2; ++k) dst[n][k] = *(const PG8_LAS bf16x8*)(lds + PG8_SB(b, h) + boff + n * 2048 + k * 1024); } while (0)
#define PG8_MMA(ai, bj, At, Bt) do { __builtin_amdgcn_s_setprio(1); _Pragma("unroll") for (int m = 0; m < 4; ++m) _Pragma("unroll") for (int n = 0; n < 2; ++n) _Pragma("unroll") for (int k = 0; k < 2; ++k) \
        acc[ai][bj][m][n] = __builtin_amdgcn_mfma_f32_16x16x32_bf16(Bt[n][k], At[m][k], acc[ai][bj][m][n], 0, 0, 0); __builtin_amdgcn_s_setprio(0); } while (0)
#define PG8_WAIT_V(n) asm volatile("s_waitcnt vmcnt(" #n ")" ::: "memory")
#define PG8_WAIT_L(n) asm volatile("s_waitcnt lgkmcnt(" #n ")" ::: "memory")
#define PG8_BAR __builtin_amdgcn_s_barrier()
#define PG8_SCHED __builtin_amdgcn_sched_barrier(0)
    Unit cur, nxt; int ui = 0;
    if (!S.next(0, cur)) return;
    f32x4 acc[2][2][4][2];
#pragma unroll
    for (int a = 0; a < 2; ++a)
#pragma unroll
        for (int b = 0; b < 2; ++b)
#pragma unroll
            for (int m = 0; m < 4; ++m)
#pragma unroll
                for (int n = 0; n < 2; ++n) acc[a][b][m][n] = (f32x4){0.f, 0.f, 0.f, 0.f};
    bf16x8 At[4][2], B0[2][2], B1[2][2];
    const char* cA = (const char*)g.A + (size_t)cur.pm * tstep; const char* cB = (const char*)g.Bt + (size_t)cur.pn * tstep;
    S.a_ready(cur);
    if constexpr (SP2) {
        PG8_STAGE(PG8_SB(0, 0), cB, voffB); PG8_STAGE(PG8_SB(0, 1), cB + hstep, voffB); PG8_STAGE(PG8_SA(0, 0), cA, voffA); PG8_STAGE(PG8_SA(0, 1), cA + hstep, voffA);
        if (wr == 1) PG8_BAR;
        PG8_WAIT_V(2); PG8_BAR;
        PG8_STAGE(PG8_SB(1, 0), cB + kstep, voffB); PG8_STAGE(PG8_SA(1, 0), cA + kstepA, voffA); PG8_STAGE(PG8_SB(1, 1), cB + hstep + kstep, voffB);
        PG8_WAIT_V(6); PG8_BAR;
    } else {
        PG8_STAGE(PG8_SB(0, 0), cB, voffB); PG8_STAGE(PG8_SA(0, 0), cA, voffA); PG8_STAGE(PG8_SB(0, 1), cB + hstep, voffB); PG8_STAGE(PG8_SA(0, 1), cA + hstep, voffA);
        if (wr == 1) PG8_BAR;
        PG8_WAIT_V(4); PG8_BAR;
        PG8_STAGE(PG8_SB(1, 0), cB + kstep, voffB); PG8_STAGE(PG8_SA(1, 0), cA + kstepA, voffA); PG8_STAGE(PG8_SB(1, 1), cB + hstep + kstep, voffB);
        PG8_WAIT_V(6); PG8_BAR;
    }
    for (;;) {
        const bool has_next = S.next(ui + 1, nxt);
        const char* nA = has_next ? (const char*)g.A + (size_t)nxt.pm * tstep : cA; const char* nB = has_next ? (const char*)g.Bt + (size_t)nxt.pn * tstep : cB;
        for (int t = 0; t < nt; t += 2) {
            const bool last = (t == nt - 2);
            const char* a1 = cA + (size_t)(t + 1) * kstepA;
            const char* a2 = last ? nA : cA + (size_t)(t + 2) * kstepA; const char* b2 = last ? nB : cB + (size_t)(t + 2) * kstep;
            const char* a3 = a2 + kstepA; const char* b3 = b2 + kstep;
            if (last && has_next) S.a_ready(nxt);
            if constexpr (SP2) {
            PG8_LDB(B0, 0, 0); PG8_LDB(B1, 0, 1); PG8_SCHED; PG8_LDA(At, 0, 0); PG8_STAGE(PG8_SA(1, 1), a1 + hstep, voffA);
            PG8_WAIT_V(8); PG8_WAIT_L(0); PG8_BAR; PG8_MMA(0, 0, At, B0); PG8_MMA(0, 1, At, B1); PG8_BAR; PG8_SCHED;
            PG8_LDA(At, 0, 1); PG8_STAGE(PG8_SB(0, 0), b2, voffB); PG8_STAGE(PG8_SB(0, 1), b2 + hstep, voffB); PG8_STAGE(PG8_SA(0, 0), a2, voffA);
            PG8_WAIT_V(8); PG8_WAIT_L(0); PG8_BAR; PG8_MMA(1, 0, At, B0); PG8_MMA(1, 1, At, B1); PG8_BAR; PG8_SCHED;
            PG8_LDB(B0, 1, 0); PG8_LDB(B1, 1, 1); PG8_SCHED; PG8_LDA(At, 1, 0); PG8_STAGE(PG8_SA(0, 1), a2 + hstep, voffA);
            PG8_WAIT_V(8); PG8_WAIT_L(0); PG8_BAR; PG8_MMA(0, 0, At, B0); PG8_MMA(0, 1, At, B1); PG8_BAR; PG8_SCHED;
            PG8_LDA(At, 1, 1); PG8_STAGE(PG8_SB(1, 0), b3, voffB); PG8_STAGE(PG8_SB(1, 1), b3 + hstep, voffB); PG8_STAGE(PG8_SA(1, 0), a3, voffA);
            PG8_WAIT_V(8); PG8_WAIT_L(0); PG8_BAR; PG8_MMA(1, 0, At, B0); PG8_MMA(1, 1, At, B1); PG8_BAR; PG8_SCHED;
            } else {
            PG8_LDB(B0, 0, 0); PG8_SCHED; PG8_LDA(At, 0, 0); PG8_STAGE(PG8_SA(1, 1), a1 + hstep, voffA);
            PG8_WAIT_L(8); PG8_BAR; PG8_WAIT_L(0); PG8_MMA(0, 0, At, B0); PG8_BAR; PG8_SCHED;
            PG8_LDB(B1, 0, 1); PG8_STAGE(PG8_SB(0, 0), b2, voffB);
            PG8_BAR; PG8_WAIT_L(0); PG8_MMA(0, 1, At, B1); PG8_BAR;
            PG8_LDA(At, 0, 1); PG8_STAGE(PG8_SA(0, 0), a2, voffA);
            PG8_BAR; PG8_WAIT_L(0); PG8_MMA(1, 0, At, B0); PG8_BAR; PG8_SCHED;
            PG8_STAGE(PG8_SB(0, 1), b2 + hstep, voffB);
            PG8_WAIT_V(6); PG8_BAR; PG8_MMA(1, 1, At, B1); PG8_BAR;
            PG8_LDB(B0, 1, 0); PG8_SCHED; PG8_LDA(At, 1, 0); PG8_STAGE(PG8_SA(0, 1), a2 + hstep, voffA);
            PG8_WAIT_L(8); PG8_BAR; PG8_WAIT_L(0); PG8_MMA(0, 0, At, B0); PG8_BAR; PG8_SCHED;
            PG8_LDB(B1, 1, 1); PG8_STAGE(PG8_SB(1, 0), b3, voffB);
            PG8_BAR; PG8_WAIT_L(0); PG8_MMA(0, 1, At, B1); PG8_BAR;
            PG8_LDA(At, 1, 1); PG8_STAGE(PG8_SA(1, 0), a3, voffA);
            PG8_BAR; PG8_WAIT_L(0); PG8_MMA(1, 0, At, B0); PG8_BAR; PG8_SCHED;
            PG8_STAGE(PG8_SB(1, 1), b3 + hstep, voffB);
            PG8_WAIT_V(6); PG8_BAR; PG8_MMA(1, 1, At, B1); PG8_BAR;
            }
        }
        if constexpr (ALIGN_EPI) { if (wr == 0) PG8_BAR; }
        if constexpr (!Epi::AFTER_DRAIN) { E(acc, cur, wr, wc, fr, fq); S.done(cur); }
        if (!has_next) break;
#pragma unroll
        for (int a = 0; a < 2; ++a)
#pragma unroll
            for (int b = 0; b < 2; ++b)
#pragma unroll
                for (int m = 0; m < 4; ++m)
#pragma unroll
                    for (int n = 0; n < 2; ++n) acc[a][b][m][n] = (f32x4){0.f, 0.f, 0.f, 0.f};
        cur = nxt; cA = nA; cB = nB; ++ui;
        if constexpr (ALIGN_EPI) { if (wr == 1) PG8_BAR; }
    }
    PG8_WAIT_V(0);
    if constexpr (!ALIGN_EPI) { if (wr == 0) PG8_BAR; }
    PG8_BAR;
    if constexpr (Epi::AFTER_DRAIN) { E.fused(acc, cur, wr, wc, fr, fq, lds, wid, lane); S.done(cur); }
#undef PG8_SA
#undef PG8_SB
#undef PG8_STAGE
#undef PG8_LDA
#undef PG8_LDB
#undef PG8_MMA
#undef PG8_WAIT_V
#undef PG8_WAIT_L
#undef PG8_BAR
#undef PG8_SCHED
}
}

#define LAS __attribute__((address_space(3)))
typedef unsigned short bf16;
typedef short bf16x8 __attribute__((ext_vector_type(8)));
typedef short s16x4 __attribute__((ext_vector_type(4)));
typedef short v4i16_t __attribute__((ext_vector_type(4)));
typedef float f32x4 __attribute__((ext_vector_type(4)));
typedef unsigned u32x4 __attribute__((ext_vector_type(4)));
typedef unsigned u32x2 __attribute__((ext_vector_type(2)));
typedef LAS unsigned char* ldsp;

constexpr int BATCH = 8, SEQ = 8192, DM = 1024, DEPTH = 4, CHUNK = 64, MTOK = BATCH * SEQ, FF = 4096, NCH = SEQ / CHUNK;
constexpr int ABW = 2560, QKVW = 3072;
constexpr float RMS_EPS = 1e-6f, GN_EPS = 1e-5f, LOG2E = 1.4426950408889634f;
constexpr float QC2 = 0.125f * LOG2E;
constexpr int NWAVES = 8, NTHR = 512;
constexpr int LDS_BYTES = 147456;
constexpr int PITCH = 272;

constexpr size_t MiB = 1u << 20;
constexpr size_t WS_SSQ = 1000 * MiB;
constexpr size_t WS_ROT = 4 * MiB;
constexpr size_t WS_W = 8 * MiB;
constexpr size_t W_FFN = 0;
constexpr size_t W_EVEN = 64 * MiB;
constexpr size_t W_ODD = 80 * MiB;
constexpr size_t WS_XB = 104 * MiB;
constexpr size_t WS_KV = 232 * MiB;
constexpr size_t WS_BIG = 488 * MiB;
constexpr size_t WS_END = 1008 * MiB;

__device__ __forceinline__ unsigned f2bf(float f) { unsigned u = __builtin_bit_cast(unsigned, f); return (u + 0x7fffu + ((u >> 16) & 1u)) >> 16; }
typedef float f32x2_t __attribute__((ext_vector_type(2))); typedef __bf16 bf16x2_t __attribute__((ext_vector_type(2)));
__device__ __forceinline__ unsigned pk2(float lo, float hi) { const f32x2_t v = {lo, hi}; const bf16x2_t b = __builtin_convertvector(v, bf16x2_t); return __builtin_bit_cast(unsigned, b); }
__device__ __forceinline__ float bflo(unsigned u) { return __builtin_bit_cast(float, u << 16); }
__device__ __forceinline__ float bfhi(unsigned u) { return __builtin_bit_cast(float, u & 0xffff0000u); }
__device__ __forceinline__ bf16x8 lds_rd16(ldsp p) { return *(const LAS bf16x8*)p; }
__device__ __forceinline__ s16x4 lds_tr(ldsp p) { return __builtin_bit_cast(s16x4, __builtin_amdgcn_ds_read_tr16_b64_v4i16((LAS v4i16_t*)p)); }
__device__ __forceinline__ bf16x8 trfrag(ldsp p, int second_off) { const s16x4 lo = lds_tr(p), hi = lds_tr(p + second_off); return (bf16x8){lo[0], lo[1], lo[2], lo[3], hi[0], hi[1], hi[2], hi[3]}; }
__device__ __forceinline__ bf16x8 pack8(f32x4 a, f32x4 b) { u32x4 w; w.x = pk2(a[0], a[1]); w.y = pk2(a[2], a[3]); w.z = pk2(b[0], b[1]); w.w = pk2(b[2], b[3]); return __builtin_bit_cast(bf16x8, w); }
#define EX2(x) __builtin_amdgcn_exp2f(x)
#define MFMA16(a, b, c) __builtin_amdgcn_mfma_f32_16x16x32_bf16((a), (b), (c), 0, 0, 0)
__device__ __forceinline__ float wave_sum(float v) {
#pragma unroll
    for (int o = 1; o < 64; o <<= 1) v += __shfl_xor(v, o);
    return v;
}
__device__ __forceinline__ void swap16(float& a, float& b) { asm("s_nop 1\n\tv_permlane16_swap_b32 %0, %1" : "+v"(a), "+v"(b)); }
__device__ __forceinline__ void swap32(float& a, float& b) { asm("s_nop 1\n\tv_permlane32_swap_b32 %0, %1" : "+v"(a), "+v"(b)); }
__device__ __forceinline__ float xrow_sum(float v) {
    float a = v, b = v; swap16(a, b); v = a + b;
    a = v; b = v; swap32(a, b); return a + b;
}
__device__ __forceinline__ float xrow_max(float v) {
    float a = v, b = v; swap16(a, b); v = fmaxf(a, b);
    a = v; b = v; swap32(a, b); return fmaxf(a, b);
}
__device__ __forceinline__ float head_lg(int h) { asm volatile("" : "+s"(h)); return log2f(1.0f - exp2f(-5.0f - (float)h)); }

__device__ __forceinline__ float row_rstd(const float* ssq, size_t row) {
    const f32x4* p = (const f32x4*)(ssq + row * 16);
    const f32x4 a = p[0], b = p[1], c = p[2], d = p[3];
    const float s = (((a[0] + a[1]) + (a[2] + a[3])) + ((b[0] + b[1]) + (b[2] + b[3]))) + (((c[0] + c[1]) + (c[2] + c[3])) + ((d[0] + d[1]) + (d[2] + d[3])));
    return rsqrtf(s * (1.0f / DM) + RMS_EPS);
}
__device__ __forceinline__ size_t xb_off(int row, int col) { return ((size_t)(row >> 4) * (DM >> 5) + (col >> 5)) * 512 + (row & 15) * 32 + (col & 31); }
template <int MODE> struct EpiProj {
    static constexpr bool PERM = true, AFTER_DRAIN = false;
    bf16* O; int ldc; const float* ssq; const float* rot;
    __device__ __forceinline__ void operator()(const pg8::f32x4 (&acc)[2][2][4][2], const pg8::Unit& u, int wr, int wc, int fr, int fq) const {
        const int row0 = u.pm * 256 + wr * 64 + fr, colt = u.pn * 256 + wc * 32 + 8 * fq;
        float rstd[8];
        if (MODE == 1) {
#pragma unroll
            for (int r8 = 0; r8 < 8; ++r8) rstd[r8] = 1.0f;
        } else {
            f32x4 pr[8];
#pragma unroll
            for (int r8 = 0; r8 < 8; ++r8) pr[r8] = *(const f32x4*)(ssq + (size_t)(row0 + (r8 >> 2) * 128 + (r8 & 3) * 16) * 16 + 4 * fq);
#pragma unroll
            for (int r8 = 0; r8 < 8; ++r8) { const float s4 = xrow_sum((pr[r8][0] + pr[r8][1]) + (pr[r8][2] + pr[r8][3])); rstd[r8] = rsqrtf(s4 * (1.0f / DM) + RMS_EPS); }
        }
        if (MODE == 0 && u.pn < 4) {
            f32x4 rc[2][2][2];
            const int pairi = (colt & 127) >> 1;
#define EPI_ROT_LOAD(bt, buf) do { _Pragma("unroll") for (int rr = 0; rr < 2; ++rr) { const int r8 = (bt) * 2 + rr; const int pos = (row0 + (r8 >> 2) * 128 + (r8 & 3) * 16) & (SEQ - 1); \
                const f32x4* rp = (const f32x4*)(rot + ((size_t)pos * 64 + pairi) * 2); rc[buf][rr][0] = rp[0]; rc[buf][rr][1] = rp[1]; } } while (0)
            EPI_ROT_LOAD(0, 0);
            const float sc = (u.pn >= 2) ? 0.08838834764831845f : 1.0f;
#pragma unroll
            for (int bt = 0; bt < 4; ++bt) {
                if (bt < 3) EPI_ROT_LOAD(bt + 1, (bt + 1) & 1);
#pragma unroll
                for (int rr = 0; rr < 2; ++rr) { const int r8 = bt * 2 + rr, ai = r8 >> 2, m = r8 & 3; const int row = row0 + ai * 128 + m * 16;
                    const f32x4 c0 = rc[bt & 1][rr][0], c1 = rc[bt & 1][rr][1]; const float rs = rstd[r8] * sc;
#pragma unroll
                    for (int bj = 0; bj < 2; ++bj) {
                        const f32x4 v0 = acc[ai][bj][m][0] * rs, v1 = acc[ai][bj][m][1] * rs;
                        f32x4 r0, r1;
                        r0[0] = v0[0] * c0[0] - v0[1] * c0[1]; r0[1] = v0[0] * c0[1] + v0[1] * c0[0];
                        r0[2] = v0[2] * c0[2] - v0[3] * c0[3]; r0[3] = v0[2] * c0[3] + v0[3] * c0[2];
                        r1[0] = v1[0] * c1[0] - v1[1] * c1[1]; r1[1] = v1[0] * c1[1] + v1[1] * c1[0];
                        r1[2] = v1[2] * c1[2] - v1[3] * c1[3]; r1[3] = v1[2] * c1[3] + v1[3] * c1[2];
                        u32x4 w; w.x = pk2(r0[0], r0[1]); w.y = pk2(r0[2], r0[3]); w.z = pk2(r1[0], r1[1]); w.w = pk2(r1[2], r1[3]);
                        *(u32x4*)(O + (size_t)row * ldc + colt + bj * 128) = w;
                    } }
            }
#undef EPI_ROT_LOAD
        } else {
            const float sc = (MODE == 2 && u.pn < 4) ? QC2 : 1.0f;
#pragma unroll
            for (int r8 = 0; r8 < 8; ++r8) { const int ai = r8 >> 2, m = r8 & 3; const int row = row0 + ai * 128 + m * 16; const float rs = rstd[r8] * sc;
#pragma unroll
                for (int bj = 0; bj < 2; ++bj) {
                    f32x4 v0 = acc[ai][bj][m][0] * rs, v1 = acc[ai][bj][m][1] * rs;
                    if (MODE == 1) {
#pragma unroll
                        for (int e = 0; e < 4; ++e) { const float a = fmaxf(v0[e], 0.f), b = fmaxf(v1[e], 0.f); v0[e] = a * a; v1[e] = b * b; }
                    }
                    u32x4 w; w.x = pk2(v0[0], v0[1]); w.y = pk2(v0[2], v0[3]); w.z = pk2(v1[0], v1[1]); w.w = pk2(v1[2], v1[3]);
                    if (MODE == 1) { const int col = colt + bj * 128;
                        *(u32x4*)(O + ((size_t)(row >> 4) * (ldc >> 5) + (col >> 5)) * 512 + (row & 15) * 32 + (col & 31)) = w; }
                    else *(u32x4*)(O + (size_t)row * ldc + colt + bj * 128) = w;
                } }
        }
    }
};
struct EpiRes {
    static constexpr bool PERM = true, AFTER_DRAIN = false;
    const float* basef; float* out; bf16* xb; float* ssq_next; const float* ssq_scale;
    __device__ __forceinline__ void operator()(const pg8::f32x4 (&acc)[2][2][4][2], const pg8::Unit& u, int wr, int wc, int fr, int fq) const {
        const int row0 = u.pm * 256 + wr * 64 + fr, colt = u.pn * 256 + wc * 32 + 8 * fq;
        if (basef) {
            f32x4 bb[2][2][2];
#define EPI_RES_LOAD(r8_, buf) do { const float* bp = basef + (size_t)(row0 + ((r8_) >> 2) * 128 + ((r8_) & 3) * 16) * DM + colt; \
                _Pragma("unroll") for (int bj = 0; bj < 2; ++bj) { bb[buf][bj][0] = *(const f32x4*)(bp + bj * 128); bb[buf][bj][1] = *(const f32x4*)(bp + bj * 128 + 4); } } while (0)
            EPI_RES_LOAD(0, 0);
#pragma unroll
            for (int r8 = 0; r8 < 8; ++r8) {
                if (r8 < 7) EPI_RES_LOAD(r8 + 1, (r8 + 1) & 1);
                const int ai = r8 >> 2, m = r8 & 3; const int row = row0 + ai * 128 + m * 16;
                float sq = 0.f;
#pragma unroll
                for (int bj = 0; bj < 2; ++bj) {
                    const size_t off = (size_t)row * DM + colt + bj * 128;
                    const f32x4 v0 = acc[ai][bj][m][0] + bb[r8 & 1][bj][0], v1 = acc[ai][bj][m][1] + bb[r8 & 1][bj][1];
                    if (out) { *(f32x4*)(out + off) = v0; *(f32x4*)(out + off + 4) = v1; }
                    u32x4 w; w.x = pk2(v0[0], v0[1]); w.y = pk2(v0[2], v0[3]); w.z = pk2(v1[0], v1[1]); w.w = pk2(v1[2], v1[3]);
                    if (xb) *(u32x4*)(xb + xb_off(row, colt + bj * 128)) = w;
                    sq += (v0[0] * v0[0] + v0[1] * v0[1]) + (v0[2] * v0[2] + v0[3] * v0[3]) + (v1[0] * v1[0] + v1[1] * v1[1]) + (v1[2] * v1[2] + v1[3] * v1[3]);
                }
                sq = xrow_sum(sq);
                if (fq == 0) ssq_next[(size_t)row * 16 + u.pn * 4 + wc] = sq;
            }
#undef EPI_RES_LOAD
        } else {
            float rf[8];
            if (ssq_scale) {
                f32x4 pr[8];
#pragma unroll
                for (int r8 = 0; r8 < 8; ++r8) pr[r8] = *(const f32x4*)(ssq_scale + (size_t)(row0 + (r8 >> 2) * 128 + (r8 & 3) * 16) * 16 + 4 * fq);
#pragma unroll
                for (int r8 = 0; r8 < 8; ++r8) { const float s4 = xrow_sum((pr[r8][0] + pr[r8][1]) + (pr[r8][2] + pr[r8][3])); rf[r8] = 1.0f / (s4 * (1.0f / DM) + RMS_EPS); }
            } else {
#pragma unroll
                for (int r8 = 0; r8 < 8; ++r8) rf[r8] = 1.0f;
            }
            u32x4 bb[2][2][2];
#define EPI_RESB_LOAD(bt, buf) do { _Pragma("unroll") for (int rr = 0; rr < 2; ++rr) { const int r8 = (bt) * 2 + rr; const int br_ = row0 + (r8 >> 2) * 128 + (r8 & 3) * 16; \
                bb[buf][rr][0] = *(const u32x4*)(xb + xb_off(br_, colt)); bb[buf][rr][1] = *(const u32x4*)(xb + xb_off(br_, colt + 128)); } } while (0)
            EPI_RESB_LOAD(0, 0);
#pragma unroll
            for (int bt = 0; bt < 4; ++bt) {
                if (bt < 3) EPI_RESB_LOAD(bt + 1, (bt + 1) & 1);
#pragma unroll
                for (int rr = 0; rr < 2; ++rr) { const int r8 = bt * 2 + rr, ai = r8 >> 2, m = r8 & 3; const int row = row0 + ai * 128 + m * 16;
                    float sq = 0.f;
#pragma unroll
                    for (int bj = 0; bj < 2; ++bj) {
                        const size_t off = (size_t)row * DM + colt + bj * 128; const u32x4 bw = bb[bt & 1][rr][bj];
                        f32x4 v0 = acc[ai][bj][m][0] * rf[r8], v1 = acc[ai][bj][m][1] * rf[r8];
                        v0[0] += bflo(bw.x); v0[1] += bfhi(bw.x); v0[2] += bflo(bw.y); v0[3] += bfhi(bw.y); v1[0] += bflo(bw.z); v1[1] += bfhi(bw.z); v1[2] += bflo(bw.w); v1[3] += bfhi(bw.w);
                        if (out) { *(f32x4*)(out + off) = v0; *(f32x4*)(out + off + 4) = v1; }
                        else { u32x4 w; w.x = pk2(v0[0], v0[1]); w.y = pk2(v0[2], v0[3]); w.z = pk2(v1[0], v1[1]); w.w = pk2(v1[2], v1[3]); *(u32x4*)(xb + xb_off(row, colt + bj * 128)) = w; }
                        sq += (v0[0] * v0[0] + v0[1] * v0[1]) + (v0[2] * v0[2] + v0[3] * v0[3]) + (v1[0] * v1[0] + v1[1] * v1[1]) + (v1[2] * v1[2] + v1[3] * v1[3]);
                    }
                    sq = xrow_sum(sq);
                    if (fq == 0) ssq_next[(size_t)row * 16 + u.pn * 4 + wc] = sq; }
            }
#undef EPI_RESB_LOAD
        }
    }
};
__device__ __forceinline__ void transpose_item(const float* W, int K, int N, int ldw, const float* gain, bf16* WT, LAS float* scr, int item, int lane) {
    const int nblk = N / 32, kb = item / nblk, nb = item % nblk, k0 = 64 * kb, n0 = 32 * nb;
#pragma unroll 8
    for (int i = 0; i < 32; ++i) { const int kk = 2 * i + (lane >> 5); const float gsc = gain ? gain[k0 + kk] : 1.0f; scr[kk * 33 + (lane & 31)] = W[(size_t)(k0 + kk) * ldw + n0 + (lane & 31)] * gsc; }
    asm volatile("s_waitcnt lgkmcnt(0)" ::: "memory");
    const int c = lane & 7;
#pragma unroll
    for (int j = 0; j < 4; ++j) { const int n = (lane >> 3) + 8 * j; const LAS float* s = scr + (8 * c) * 33 + n;
        u32x4 o; o.x = pk2(s[0 * 33], s[1 * 33]); o.y = pk2(s[2 * 33], s[3 * 33]); o.z = pk2(s[4 * 33], s[5 * 33]); o.w = pk2(s[6 * 33], s[7 * 33]);
        *(u32x4*)(WT + (size_t)(n0 + n) * K + k0 + 8 * c) = o; }
    asm volatile("s_waitcnt lgkmcnt(0)" ::: "memory");
}

struct Params {
    const float* x; const float* mix_norm; const float* ffn_norm; const float* w_ffn_in; const float* w_ffn_out;
    const float* ab_w_in; const float* ab_gn_gain; const float* ab_w_pool; const float* ab_pool_scale; const float* ab_w_out;
    const float* c_w_qkv; const float* c_rel_bias; const float* c_w_out; const float* final_norm;
    float* out; unsigned char* ws; int ph_lo, ph_hi;
};

__device__ __forceinline__ void prologue(const Params& P, ldsp lds, int tid, int wave, int lane, int vcu, int G) {
    unsigned char* ws = P.ws;
    bf16* Wb = (bf16*)(ws + WS_W);
    LAS float* scr = (LAS float*)(lds + wave * 16384);
    const int gw = vcu * NWAVES + wave, NGW = G * NWAVES;
    constexpr int I_FFN = 8 * 2048, I_EVEN1 = 1280 + 512 + 32, I_ODD1 = 1536 + 512, NITEMS = I_FFN + 2 * I_EVEN1 + 2 * I_ODD1;
    for (int it = gw; it < NITEMS; it += NGW) {
        int r = it;
        if (r < I_FFN) { const int mat = r >> 11, L = mat >> 1; r &= 2047;
            if ((mat & 1) == 0) transpose_item(P.w_ffn_in + (size_t)L * DM * FF, DM, FF, FF, P.ffn_norm + L * DM, Wb + (W_FFN + (size_t)L * 16 * MiB) / 2, scr, r, lane);
            else transpose_item(P.w_ffn_out + (size_t)L * FF * DM, FF, DM, DM, nullptr, Wb + (W_FFN + (size_t)L * 16 * MiB + 8 * MiB) / 2, scr, r, lane);
            continue; }
        r -= I_FFN;
        if (r < 2 * I_EVEN1) { const int i = r / I_EVEN1; r -= i * I_EVEN1; bf16* base = Wb + (W_EVEN + (size_t)i * 8 * MiB) / 2;
            if (r < 1280) { transpose_item(P.ab_w_in + (size_t)i * DM * ABW, DM, ABW, ABW, P.mix_norm + (2 * i) * DM, base, scr, r, lane); continue; }
            r -= 1280;
            if (r < 512) { transpose_item(P.ab_w_out + (size_t)i * DM * DM, DM, DM, DM, nullptr, base + (5 * MiB) / 2, scr, r, lane); continue; }
            r -= 512;
            { const int gi = r >> 3; r &= 7; transpose_item(P.ab_w_pool + ((size_t)i * 4 + gi) * 128 * 128, 128, 128, 128, nullptr, base + (7 * MiB) / 2 + gi * 128 * 128, scr, r, lane); }
            continue; }
        r -= 2 * I_EVEN1;
        { const int i = r / I_ODD1; r -= i * I_ODD1; bf16* base = Wb + (W_ODD + (size_t)i * 8 * MiB) / 2;
            if (r < 1536) transpose_item(P.c_w_qkv + (size_t)i * DM * QKVW, DM, QKVW, QKVW, P.mix_norm + (2 * i + 1) * DM, base, scr, r, lane);
            else transpose_item(P.c_w_out + (size_t)i * DM * DM, DM, DM, DM, nullptr, base + (6 * MiB) / 2, scr, r - 1536, lane); }
    }
    float* ssq = (float*)(ws + WS_SSQ);
    bf16* XB = (bf16*)(ws + WS_XB);
    for (int m0 = gw * 4; m0 < MTOK; m0 += NGW * 4) {
        f32x4 v[4][4];
#pragma unroll
        for (int r = 0; r < 4; ++r) { const f32x4* xr = (const f32x4*)(P.x + (size_t)(m0 + r) * DM) + lane;
#pragma unroll
            for (int j = 0; j < 4; ++j) v[r][j] = xr[64 * j]; }
#pragma unroll
        for (int r = 0; r < 4; ++r) { float s = 0.f;
#pragma unroll
            for (int j = 0; j < 4; ++j) { const f32x4 t = v[r][j]; s += (t[0] * t[0] + t[1] * t[1]) + (t[2] * t[2] + t[3] * t[3]); u32x2 w; w.x = pk2(t[0], t[1]); w.y = pk2(t[2], t[3]); *(u32x2*)(XB + xb_off(m0 + r, 4 * lane + 256 * j)) = w; }
            s = wave_sum(s);
            if (lane < 16) ssq[(size_t)(m0 + r) * 16 + lane] = (lane == 0) ? s : 0.f; }
    }
    const int gt = vcu * NTHR + tid, NGT = G * NTHR;
    float* rot = (float*)(ws + WS_ROT);
    for (int i = gt; i < SEQ * 64; i += NGT) {
        const int pos = i >> 6, fi = i & 63;
        const float invf = (float)exp2(-(double)fi * (13.287712379549449 / 63.0));
        const float ang = (float)pos * invf;
        const double rev = (double)ang * 0.15915494309189535;
        const double fr = rev - floor(rev);
        const float a = (float)(fr * 6.283185307179586);
        rot[2 * i] = __cosf(a); rot[2 * i + 1] = __sinf(a);
    }
}

#define RET_KV_UPDATE(Kd_, Vs_) do { _Pragma("unroll") for (int ks = 0; ks < 2; ++ks) { \
        const int rowoff = (ks * 32 + g * 8 + (i >> 2)) * PITCH + 8 * (i & 3); \
        const bf16x8 Bv = trfrag((Vs_) + rowoff + wave * 32, 4 * PITCH); \
        _Pragma("unroll") for (int dt = 0; dt < 8; ++dt) { const bf16x8 Ak = trfrag((Kd_) + rowoff + dt * 32, 4 * PITCH); st[dt] = MFMA16(Ak, Bv, st[dt]); } } } while (0)
__device__ __forceinline__ void retA_phase(ldsp lds, const bf16* z, float* TS, int vcu, int G, int tid, int wave, int lane) {
    ldsp Kd = lds, Vs = lds + 64 * PITCH;
    const int i = lane & 15, g = lane >> 4, lr = tid >> 4, lc = tid & 15;
    u32x4 kreg[2], vreg[2];
    for (int unit = vcu; unit < 256; unit += G) {
        const int bh = unit >> 3, seg = unit & 7, h = bh & 3;
        const float lg = head_lg(h), cd = EX2(64.0f * lg);
        const bf16* zb = z + ((size_t)(bh >> 2) * SEQ + (size_t)seg * 1024 + lr) * ABW + h * 128 + lc * 8;
#define RA_LOAD(cc) do { _Pragma("unroll") for (int it = 0; it < 2; ++it) { const bf16* src = zb + ((size_t)(cc) * 64 + it * 32) * ABW; kreg[it] = *(const u32x4*)(src + 512); vreg[it] = *(const u32x4*)(src + 1024); } } while (0)
        RA_LOAD(0);
        f32x4 st[8];
#pragma unroll
        for (int dt = 0; dt < 8; ++dt) st[dt] = (f32x4){0.f, 0.f, 0.f, 0.f};
        for (int cc = 0; cc < 16; ++cc) {
#pragma unroll
            for (int it = 0; it < 2; ++it) {
                const int r = lr + it * 32; const float dk = EX2((float)(63 - r) * lg);
                u32x4 kk = kreg[it];
                kk.x = pk2(bflo(kk.x) * dk, bfhi(kk.x) * dk); kk.y = pk2(bflo(kk.y) * dk, bfhi(kk.y) * dk); kk.z = pk2(bflo(kk.z) * dk, bfhi(kk.z) * dk); kk.w = pk2(bflo(kk.w) * dk, bfhi(kk.w) * dk);
                *(LAS u32x4*)(Kd + r * PITCH + lc * 16) = kk; *(LAS u32x4*)(Vs + r * PITCH + lc * 16) = vreg[it];
            }
            __syncthreads();
            RA_LOAD(cc < 15 ? cc + 1 : cc);
#pragma unroll
            for (int dt = 0; dt < 8; ++dt) st[dt] = st[dt] * cd;
            RET_KV_UPDATE(Kd, Vs);
            __syncthreads();
        }
#undef RA_LOAD
        float* dst = TS + ((size_t)unit * 128 + wave * 16 + i) * 128 + g * 4;
#pragma unroll
        for (int dt = 0; dt < 8; ++dt) *(f32x4*)(dst + dt * 16) = st[dt];
    }
}

__device__ __forceinline__ void pool_phase(ldsp lds, const bf16* z, const bf16* WpT, const float* scale, bf16* CAT, int vcu, int G, int tid, int wave, int lane) {
    ldsp Ps = lds, PO = lds + 80 * PITCH;
    const int i = lane & 15, g = lane >> 4;
    const int gi = vcu & 3, wdw = 2 << gi;
    bf16x8 af[4];
#pragma unroll
    for (int ks = 0; ks < 4; ++ks) af[ks] = *(const bf16x8*)(WpT + (size_t)(gi * 128 + wave * 16 + i) * 128 + ks * 32 + g * 8);
    const f32x4 sc = *(const f32x4*)(scale + gi * 128 + wave * 16 + g * 4);
    u32x4 preg[3];
    const int nbc = BATCH * NCH;
#define POOL_LOAD(bc) do { const int c_ = (bc) & 127, b_ = (bc) >> 7; \
        _Pragma("unroll") for (int it = 0; it < 3; ++it) { const int ch = tid + it * 512, r = ch >> 4, cc = ch & 15, tok = c_ * 64 - 16 + r; preg[it] = (u32x4){0u, 0u, 0u, 0u}; \
            if (ch < 1280 && tok >= 0) preg[it] = *(const u32x4*)(z + ((size_t)b_ * SEQ + tok) * ABW + 2048 + gi * 128 + cc * 8); } } while (0)
    int bc = vcu >> 2; const int step = G >> 2;
    if (bc < nbc) POOL_LOAD(bc);
    for (; bc < nbc; bc += step) {
        const int c = bc & 127, b = bc >> 7;
        const size_t row0 = (size_t)b * SEQ + c * 64;
#pragma unroll
        for (int it = 0; it < 3; ++it) { const int ch = tid + it * 512; if (ch < 1280) *(LAS u32x4*)(Ps + (ch >> 4) * PITCH + (ch & 15) * 16) = preg[it]; }
        __syncthreads();
        if (bc + step < nbc) POOL_LOAD(bc + step);
        {
            const int t = tid >> 3, cb = (tid & 7) * 32;
            float s[16];
#pragma unroll
            for (int e = 0; e < 16; ++e) s[e] = 0.f;
            for (int jj = 0; jj < wdw; ++jj) {
                const ldsp p = Ps + (16 + t - jj) * PITCH + cb;
                const u32x4 a = *(const LAS u32x4*)p, b2 = *(const LAS u32x4*)(p + 16);
                s[0] += bflo(a.x); s[1] += bfhi(a.x); s[2] += bflo(a.y); s[3] += bfhi(a.y); s[4] += bflo(a.z); s[5] += bfhi(a.z); s[6] += bflo(a.w); s[7] += bfhi(a.w);
                s[8] += bflo(b2.x); s[9] += bfhi(b2.x); s[10] += bflo(b2.y); s[11] += bfhi(b2.y); s[12] += bflo(b2.z); s[13] += bfhi(b2.z); s[14] += bflo(b2.w); s[15] += bfhi(b2.w);
            }
            const int cnt = min(c * 64 + t + 1, wdw); const float inv = 1.0f / (float)cnt;
            const ldsp p0 = Ps + (16 + t) * PITCH + cb;
            const u32x4 a = *(const LAS u32x4*)p0, b2 = *(const LAS u32x4*)(p0 + 16);
            u32x4 o0, o1;
            o0.x = pk2(s[0] * inv - bflo(a.x), s[1] * inv - bfhi(a.x)); o0.y = pk2(s[2] * inv - bflo(a.y), s[3] * inv - bfhi(a.y));
            o0.z = pk2(s[4] * inv - bflo(a.z), s[5] * inv - bfhi(a.z)); o0.w = pk2(s[6] * inv - bflo(a.w), s[7] * inv - bfhi(a.w));
            o1.x = pk2(s[8] * inv - bflo(b2.x), s[9] * inv - bfhi(b2.x)); o1.y = pk2(s[10] * inv - bflo(b2.y), s[11] * inv - bfhi(b2.y));
            o1.z = pk2(s[12] * inv - bflo(b2.z), s[13] * inv - bfhi(b2.z)); o1.w = pk2(s[14] * inv - bflo(b2.w), s[15] * inv - bfhi(b2.w));
            *(LAS u32x4*)(PO + t * PITCH + cb) = o0; *(LAS u32x4*)(PO + t * PITCH + cb + 16) = o1;
        }
        __syncthreads();
#pragma unroll
        for (int tt = 0; tt < 4; ++tt) {
            f32x4 acc = (f32x4){0.f, 0.f, 0.f, 0.f};
#pragma unroll
            for (int ks = 0; ks < 4; ++ks) { const bf16x8 bfr = lds_rd16(PO + (tt * 16 + i) * PITCH + (ks * 32 + g * 8) * 2); acc = MFMA16(af[ks], bfr, acc); }
            acc = acc * sc;
            u32x2 w; w.x = pk2(acc[0], acc[1]); w.y = pk2(acc[2], acc[3]);
            *(u32x2*)(CAT + (row0 + tt * 16 + i) * DM + 512 + gi * 128 + wave * 16 + g * 4) = w;
        }
        __syncthreads();
    }
#undef POOL_LOAD
}

__device__ __forceinline__ void retA_pool_phase(ldsp lds, const bf16* z, float* TS, const bf16* WpT, const float* scale, bf16* CAT, int vcu, int tid, int wave, int lane) {
    ldsp Kd = lds, Vs = lds + 64 * PITCH, Ps = lds + 128 * PITCH, PO = lds + 208 * PITCH;
    const int i = lane & 15, g = lane >> 4, lr = tid >> 4, lc = tid & 15;
    const int unit = vcu, bh = unit >> 3, seg = unit & 7, h = bh & 3;
    const float lg = head_lg(h), cd = EX2(64.0f * lg);
    const bf16* zb = z + ((size_t)(bh >> 2) * SEQ + (size_t)seg * 1024 + lr) * ABW + h * 128 + lc * 8;
    u32x4 kreg[2], vreg[2];
#define RA_LOAD(cc) do { _Pragma("unroll") for (int it = 0; it < 2; ++it) { const bf16* src = zb + ((size_t)(cc) * 64 + it * 32) * ABW; kreg[it] = *(const u32x4*)(src + 512); vreg[it] = *(const u32x4*)(src + 1024); } } while (0)
    const int gi = vcu & 3, wdw = 2 << gi;
    bf16x8 af[4];
#pragma unroll
    for (int ks = 0; ks < 4; ++ks) af[ks] = *(const bf16x8*)(WpT + (size_t)(gi * 128 + wave * 16 + i) * 128 + ks * 32 + g * 8);
    const f32x4 sc = *(const f32x4*)(scale + gi * 128 + wave * 16 + g * 4);
    u32x4 preg[3];
#define POOL_LOAD(bc) do { const int c_ = (bc) & 127, b_ = (bc) >> 7; \
        _Pragma("unroll") for (int it = 0; it < 3; ++it) { const int ch = tid + it * 512, r = ch >> 4, cc = ch & 15, tok = c_ * 64 - 16 + r; preg[it] = (u32x4){0u, 0u, 0u, 0u}; \
            if (ch < 1280 && tok >= 0) preg[it] = *(const u32x4*)(z + ((size_t)b_ * SEQ + tok) * ABW + 2048 + gi * 128 + cc * 8); } } while (0)
    RA_LOAD(0); POOL_LOAD(vcu >> 2);
    f32x4 st[8];
#pragma unroll
    for (int dt = 0; dt < 8; ++dt) st[dt] = (f32x4){0.f, 0.f, 0.f, 0.f};
    for (int k = 0; k < 16; ++k) {
        const int bc = (vcu >> 2) + 64 * k, c = bc & 127, b = bc >> 7;
        const size_t row0 = (size_t)b * SEQ + c * 64;
#pragma unroll
        for (int it = 0; it < 2; ++it) {
            const int r = lr + it * 32; const float dk = EX2((float)(63 - r) * lg);
            u32x4 kk = kreg[it];
            kk.x = pk2(bflo(kk.x) * dk, bfhi(kk.x) * dk); kk.y = pk2(bflo(kk.y) * dk, bfhi(kk.y) * dk); kk.z = pk2(bflo(kk.z) * dk, bfhi(kk.z) * dk); kk.w = pk2(bflo(kk.w) * dk, bfhi(kk.w) * dk);
            *(LAS u32x4*)(Kd + r * PITCH + lc * 16) = kk; *(LAS u32x4*)(Vs + r * PITCH + lc * 16) = vreg[it];
        }
#pragma unroll
        for (int it = 0; it < 3; ++it) { const int ch = tid + it * 512; if (ch < 1280) *(LAS u32x4*)(Ps + (ch >> 4) * PITCH + (ch & 15) * 16) = preg[it]; }
        __syncthreads();
        { const int kn = (k < 15) ? k + 1 : k; RA_LOAD(kn); POOL_LOAD((vcu >> 2) + 64 * kn); }
#pragma unroll
        for (int dt = 0; dt < 8; ++dt) st[dt] = st[dt] * cd;
        RET_KV_UPDATE(Kd, Vs);
        {
            const int t = tid >> 3, cb = (tid & 7) * 32;
            float s[16];
#pragma unroll
            for (int e = 0; e < 16; ++e) s[e] = 0.f;
            for (int jj = 0; jj < wdw; ++jj) {
                const ldsp p = Ps + (16 + t - jj) * PITCH + cb;
                const u32x4 a = *(const LAS u32x4*)p, b2 = *(const LAS u32x4*)(p + 16);
                s[0] += bflo(a.x); s[1] += bfhi(a.x); s[2] += bflo(a.y); s[3] += bfhi(a.y); s[4] += bflo(a.z); s[5] += bfhi(a.z); s[6] += bflo(a.w); s[7] += bfhi(a.w);
                s[8] += bflo(b2.x); s[9] += bfhi(b2.x); s[10] += bflo(b2.y); s[11] += bfhi(b2.y); s[12] += bflo(b2.z); s[13] += bfhi(b2.z); s[14] += bflo(b2.w); s[15] += bfhi(b2.w);
            }
            const int cnt = min(c * 64 + t + 1, wdw); const float inv = 1.0f / (float)cnt;
            const ldsp p0 = Ps + (16 + t) * PITCH + cb;
            const u32x4 a = *(const LAS u32x4*)p0, b2 = *(const LAS u32x4*)(p0 + 16);
            u32x4 o0, o1;
            o0.x = pk2(s[0] * inv - bflo(a.x), s[1] * inv - bfhi(a.x)); o0.y = pk2(s[2] * inv - bflo(a.y), s[3] * inv - bfhi(a.y));
            o0.z = pk2(s[4] * inv - bflo(a.z), s[5] * inv - bfhi(a.z)); o0.w = pk2(s[6] * inv - bflo(a.w), s[7] * inv - bfhi(a.w));
            o1.x = pk2(s[8] * inv - bflo(b2.x), s[9] * inv - bfhi(b2.x)); o1.y = pk2(s[10] * inv - bflo(b2.y), s[11] * inv - bfhi(b2.y));
            o1.z = pk2(s[12] * inv - bflo(b2.z), s[13] * inv - bfhi(b2.z)); o1.w = pk2(s[14] * inv - bflo(b2.w), s[15] * inv - bfhi(b2.w));
            *(LAS u32x4*)(PO + t * PITCH + cb) = o0; *(LAS u32x4*)(PO + t * PITCH + cb + 16) = o1;
        }
        __syncthreads();
#pragma unroll
        for (int tt = 0; tt < 4; ++tt) {
            f32x4 acc = (f32x4){0.f, 0.f, 0.f, 0.f};
#pragma unroll
            for (int ks = 0; ks < 4; ++ks) { const bf16x8 bfr = lds_rd16(PO + (tt * 16 + i) * PITCH + (ks * 32 + g * 8) * 2); acc = MFMA16(af[ks], bfr, acc); }
            acc = acc * sc;
            u32x2 w; w.x = pk2(acc[0], acc[1]); w.y = pk2(acc[2], acc[3]);
            *(u32x2*)(CAT + (row0 + tt * 16 + i) * DM + 512 + gi * 128 + wave * 16 + g * 4) = w;
        }
    }
    __syncthreads();
#undef RA_LOAD
#undef POOL_LOAD
    float* dst = TS + ((size_t)unit * 128 + wave * 16 + i) * 128 + g * 4;
#pragma unroll
    for (int dt = 0; dt < 8; ++dt) *(f32x4*)(dst + dt * 16) = st[dt];
}

__device__ __forceinline__ void retB_phase(ldsp lds, const bf16* z, const float* TS, const float* gn_gain, bf16* CAT, int vcu, int G, int tid, int wave, int lane) {
    ldsp Qs = lds, Ks = lds + 64 * PITCH, Vs = lds + 128 * PITCH, Kd = lds + 256 * PITCH, STs = lds + 320 * PITCH;
    const int i = lane & 15, g = lane >> 4, nt = wave & 3, eh = wave >> 2, lr = tid >> 4, lc = tid & 15;
    u32x4 qreg[2], kreg[2], vreg[2], greg[2];
    for (int unit = vcu; unit < 256; unit += G) {
        const int bh = unit >> 3, seg = unit & 7, b = bh >> 2, h = bh & 3;
        f32x4 gg[4];
#pragma unroll
        for (int et = 0; et < 4; ++et) gg[et] = *(const f32x4*)(gn_gain + h * 128 + eh * 64 + et * 16 + g * 4);
        const float lg = head_lg(h), cd = EX2(64.0f * lg);
        const bf16* zb = z + ((size_t)b * SEQ + (size_t)seg * 1024 + lr) * ABW + h * 128 + lc * 8;
#define RB_LOAD(cc) do { _Pragma("unroll") for (int it = 0; it < 2; ++it) { const bf16* src = zb + ((size_t)(cc) * 64 + it * 32) * ABW; \
            qreg[it] = *(const u32x4*)src; kreg[it] = *(const u32x4*)(src + 512); vreg[it] = *(const u32x4*)(src + 1024); greg[it] = *(const u32x4*)(src + 1536); } } while (0)
        RB_LOAD(0);
        f32x4 st[8];
#pragma unroll
        for (int dt = 0; dt < 8; ++dt) st[dt] = (f32x4){0.f, 0.f, 0.f, 0.f};
        for (int sp = 0; sp < seg; ++sp) {
            const float wsp = EX2(1024.0f * lg * (float)(seg - 1 - sp));
            const float* src = TS + ((size_t)(bh * 8 + sp) * 128 + wave * 16 + i) * 128 + g * 4;
#pragma unroll
            for (int dt = 0; dt < 8; ++dt) st[dt] = st[dt] + *(const f32x4*)(src + dt * 16) * wsp;
        }
        for (int cc = 0; cc < 16; ++cc) {
            const size_t row0 = (size_t)b * SEQ + (size_t)(seg * 16 + cc) * 64;
            const ldsp Gs = (cc & 1) ? lds + 448 * PITCH : lds + 192 * PITCH;
            LAS float* RED = (LAS float*)(lds + 512 * PITCH) + (cc & 1) * 256;
#pragma unroll
            for (int it = 0; it < 2; ++it) { const int r = lr + it * 32, off = r * PITCH + lc * 16; const float dk = EX2((float)(63 - r) * lg);
                u32x4 kk = kreg[it];
                kk.x = pk2(bflo(kk.x) * dk, bfhi(kk.x) * dk); kk.y = pk2(bflo(kk.y) * dk, bfhi(kk.y) * dk); kk.z = pk2(bflo(kk.z) * dk, bfhi(kk.z) * dk); kk.w = pk2(bflo(kk.w) * dk, bfhi(kk.w) * dk);
                *(LAS u32x4*)(Qs + off) = qreg[it]; *(LAS u32x4*)(Ks + off) = kreg[it]; *(LAS u32x4*)(Vs + off) = vreg[it]; *(LAS u32x4*)(Gs + off) = greg[it]; *(LAS u32x4*)(Kd + off) = kk; }
#pragma unroll
            for (int dt = 0; dt < 8; ++dt) { u32x2 w; w.x = pk2(st[dt][0], st[dt][1]); w.y = pk2(st[dt][2], st[dt][3]); *(LAS u32x2*)(STs + (wave * 16 + i) * PITCH + (dt * 16 + g * 4) * 2) = w; }
            __syncthreads();
            RB_LOAD(cc < 15 ? cc + 1 : cc);
            bf16x8 qf[4];
#pragma unroll
            for (int ks = 0; ks < 4; ++ks) qf[ks] = lds_rd16(Qs + (nt * 16 + i) * PITCH + (ks * 32 + g * 8) * 2);
            f32x4 sT[4];
#pragma unroll
            for (int mt = 0; mt < 4; ++mt) { sT[mt] = (f32x4){0.f, 0.f, 0.f, 0.f};
#pragma unroll
                for (int ks = 0; ks < 4; ++ks) { const bf16x8 kf = lds_rd16(Ks + (mt * 16 + i) * PITCH + (ks * 32 + g * 8) * 2); sT[mt] = MFMA16(kf, qf[ks], sT[mt]); } }
            const int n = nt * 16 + i;
#pragma unroll
            for (int mt = 0; mt < 4; ++mt)
#pragma unroll
                for (int j = 0; j < 4; ++j) { const int m = mt * 16 + g * 4 + j; sT[mt][j] *= EX2(fabsf((float)(n - m)) * lg); }
            bf16x8 Pf[2]; Pf[0] = pack8(sT[0], sT[1]); Pf[1] = pack8(sT[2], sT[3]);
            f32x4 o[4];
            const float qd = EX2((float)(n + 1) * lg);
#pragma unroll
            for (int et = 0; et < 4; ++et) { o[et] = (f32x4){0.f, 0.f, 0.f, 0.f}; const int e0 = (eh * 4 + et) * 16;
#pragma unroll
                for (int ks = 0; ks < 4; ++ks) { const bf16x8 sf = lds_rd16(STs + (e0 + i) * PITCH + (ks * 32 + g * 8) * 2); o[et] = MFMA16(sf, qf[ks], o[et]); }
                o[et] = o[et] * qd; }
#pragma unroll
            for (int ks2 = 0; ks2 < 2; ++ks2)
#pragma unroll
                for (int et = 0; et < 4; ++et) { const int e0 = (eh * 4 + et) * 16;
                    const bf16x8 vf = trfrag(Vs + (ks2 * 32 + g * 4 + (i >> 2)) * PITCH + (e0 + 4 * (i & 3)) * 2, 16 * PITCH); o[et] = MFMA16(vf, Pf[ks2], o[et]); }
#pragma unroll
            for (int dt = 0; dt < 8; ++dt) st[dt] = st[dt] * cd;
            RET_KV_UPDATE(Kd, Vs);
            float a1 = 0.f, a2 = 0.f;
#pragma unroll
            for (int et = 0; et < 4; ++et)
#pragma unroll
                for (int j = 0; j < 4; ++j) { a1 += o[et][j]; a2 += o[et][j] * o[et][j]; }
            a1 = xrow_sum(a1); a2 = xrow_sum(a2);
            if (g == 0) { RED[(wave * 16 + i) * 2] = a1; RED[(wave * 16 + i) * 2 + 1] = a2; }
            __syncthreads();
            {
                const float pa = RED[((wave ^ 4) * 16 + i) * 2], pq = RED[((wave ^ 4) * 16 + i) * 2 + 1];
                const float mean = (a1 + pa) * (1.0f / 128.0f), var = fmaxf((a2 + pq) * (1.0f / 128.0f) - mean * mean, 0.f), rstd = rsqrtf(var + GN_EPS);
                const size_t row = row0 + n;
#pragma unroll
                for (int et = 0; et < 4; ++et) { const int e = eh * 64 + et * 16 + g * 4;
                    const u32x2 gw = *(const LAS u32x2*)(Gs + n * PITCH + e * 2);
                    const float g0 = bflo(gw.x), g1 = bfhi(gw.x), g2 = bflo(gw.y), g3 = bfhi(gw.y);
                    const float y0 = (o[et][0] - mean) * rstd * gg[et][0] * (g0 / (1.0f + __expf(-g0)));
                    const float y1 = (o[et][1] - mean) * rstd * gg[et][1] * (g1 / (1.0f + __expf(-g1)));
                    const float y2 = (o[et][2] - mean) * rstd * gg[et][2] * (g2 / (1.0f + __expf(-g2)));
                    const float y3 = (o[et][3] - mean) * rstd * gg[et][3] * (g3 / (1.0f + __expf(-g3)));
                    u32x2 w; w.x = pk2(y0, y1); w.y = pk2(y2, y3);
                    *(u32x2*)(CAT + row * DM + h * 128 + e) = w; }
            }
        }
        __syncthreads();
#undef RB_LOAD
    }
}

constexpr int KPITCH = 144, VPITCH = 160;
constexpr int ATT_BUF = 64 * KPITCH + 64 * VPITCH;
__device__ __forceinline__ void attn_phase(ldsp lds, const bf16* qkv, const float* relb, bf16* O, int vcu, int G, int tid, int wave, int lane) {
    const int head = vcu & 15;
    LAS float* BH = (LAS float*)(lds + 4 * ATT_BUF);
    for (int t2 = tid; t2 < 257; t2 += NTHR) BH[t2] = relb[head * 257 + t2] * LOG2E;
    const int i = lane & 15, g = lane >> 4, cw = wave >> 1, qh = wave & 1;
    const int lr = tid >> 3, lc = tid & 7;
    u32x4 kA, vA, kB, vB;
#define ATT_B(u_) (((u_) & 255) >> 5)
#define ATT_C0(u_) ((((u_) >> 8) * 2 + ((((u_) & 255) >> 4) & 1)) * 4)
#define ATT_T0(c0_) (((c0_) < 8) ? 0 : (c0_) - 8)
#define ATT_LOAD(KR, VR) do { const bf16* src = qkv + ((size_t)ATT_B(ul) * SEQ + (size_t)Tl * 64 + lr) * QKVW + DM + head * 64 + lc * 8; KR = *(const u32x4*)src; VR = *(const u32x4*)(src + DM); \
        if (Tl == ATT_C0(ul) + 3) { if (ul + G < 4096) { ul += G; Tl = ATT_T0(ATT_C0(ul)); } } else ++Tl; } while (0)
#define ATT_QLOAD(dst, b_, c_) do { const size_t qr_ = (size_t)(b_) * SEQ + (c_) * 64 + qh * 32 + i; \
        _Pragma("unroll") for (int qa = 0; qa < 2; ++qa) _Pragma("unroll") for (int ks = 0; ks < 2; ++ks) dst[qa][ks] = *(const bf16x8*)(qkv + (qr_ + qa * 16) * QKVW + head * 64 + ks * 32 + g * 8); } while (0)
    int u = vcu, par = 0;
    int ul = vcu, Tl = ATT_T0(ATT_C0(vcu));
    bf16x8 qf[2][2], qn[2][2];
    ATT_LOAD(kA, vA); ATT_LOAD(kB, vB);
    if (u < 4096) ATT_QLOAD(qf, ATT_B(u), ATT_C0(u) + cw);
    for (; u < 4096; u += G) {
        const int b = ATT_B(u), c0 = ATT_C0(u);
        const int c = c0 + cw;
        const int T0 = ATT_T0(c0), T1 = c0 + 3;
        const bool has_next = (u + G < 4096);
        float m_i[2] = {0.f, 0.f}, l_i[2] = {0.f, 0.f};
        const int tfirst = (c < 8) ? 8 - c : 0;
        f32x4 acc[2][4];
#pragma unroll
        for (int qa = 0; qa < 2; ++qa)
#pragma unroll
            for (int dt = 0; dt < 4; ++dt) acc[qa][dt] = (f32x4){0.f, 0.f, 0.f, 0.f};
#define ATT_STEP(Kt, T) do { \
            const ldsp Vt = (Kt) + 64 * KPITCH; \
            const int t = (T) - (c - 8);                            \
            if (t >= 0 && t <= 8) { \
                const float cb = (t <= 5) ? BH[256] : 0.f;          \
                f32x4 sT[2][4]; \
                const float i0 = cb - m_i[0], i1 = cb - m_i[1]; \
                _Pragma("unroll") for (int kt = 0; kt < 4; ++kt) { sT[0][kt] = (f32x4){i0, i0, i0, i0}; sT[1][kt] = (f32x4){i1, i1, i1, i1}; \
                    _Pragma("unroll") for (int ks = 0; ks < 2; ++ks) { const bf16x8 kf = lds_rd16(Kt + (kt * 16 + i) * KPITCH + (ks * 32 + g * 8) * 2); \
                        sT[0][kt] = MFMA16(kf, qf[0][ks], sT[0][kt]); sT[1][kt] = MFMA16(kf, qf[1][ks], sT[1][kt]); } } \
                if (t > 5) { \
                    _Pragma("unroll") for (int qa = 0; qa < 2; ++qa) { const int base = (qh * 32 + qa * 16 + i) + 640 - t * 64 - g * 4; \
                        _Pragma("unroll") for (int kt = 0; kt < 4; ++kt) \
                            _Pragma("unroll") for (int j = 0; j < 4; ++j) sT[qa][kt][j] += BH[min(base - kt * 16 - j, 256)]; } \
                } \
                bf16x8 Pb[2][2]; \
                _Pragma("unroll") for (int qa = 0; qa < 2; ++qa) { \
                    float mx = fmaxf(fmaxf(sT[qa][0][0], sT[qa][0][1]), fmaxf(sT[qa][0][2], sT[qa][0][3])); \
                    _Pragma("unroll") for (int kt = 1; kt < 4; ++kt) mx = fmaxf(mx, fmaxf(fmaxf(sT[qa][kt][0], sT[qa][kt][1]), fmaxf(sT[qa][kt][2], sT[qa][kt][3]))); \
                    mx = xrow_max(mx);                              \
                    if (t == tfirst || __any(mx > 8.0f)) {          \
                        const float dl = (t == tfirst) ? mx : fmaxf(mx, 0.f), alpha = (t == tfirst) ? 1.0f : EX2(-dl); m_i[qa] += dl;     \
                        _Pragma("unroll") for (int kt = 0; kt < 4; ++kt) sT[qa][kt] = sT[qa][kt] - dl; \
                        l_i[qa] *= alpha; \
                        _Pragma("unroll") for (int dt = 0; dt < 4; ++dt) acc[qa][dt] = acc[qa][dt] * alpha; \
                    } \
                    float rs = 0.f; \
                    _Pragma("unroll") for (int kt = 0; kt < 4; ++kt) \
                        _Pragma("unroll") for (int j = 0; j < 4; ++j) { const float p = EX2(sT[qa][kt][j]); sT[qa][kt][j] = p; rs += p; } \
                    l_i[qa] += rs; \
                    Pb[qa][0] = pack8(sT[qa][0], sT[qa][1]); Pb[qa][1] = pack8(sT[qa][2], sT[qa][3]); \
                } \
                _Pragma("unroll") for (int ks2 = 0; ks2 < 2; ++ks2) \
                    _Pragma("unroll") for (int dt = 0; dt < 4; ++dt) { const bf16x8 vf = trfrag(Vt + (ks2 * 32 + g * 4 + (i >> 2)) * VPITCH + (dt * 16 + 4 * (i & 3)) * 2, 16 * VPITCH); \
                        acc[0][dt] = MFMA16(vf, Pb[0][ks2], acc[0][dt]); acc[1][dt] = MFMA16(vf, Pb[1][ks2], acc[1][dt]); } \
            } } while (0)
        { const int un = has_next ? u + G : u; ATT_QLOAD(qn, ATT_B(un), ATT_C0(un) + cw); }
        for (int T = T0; T <= T1; T += 2) {
            const ldsp K0 = lds + (2 * par) * ATT_BUF, K1 = K0 + ATT_BUF; par ^= 1;
            *(LAS u32x4*)(K0 + lr * KPITCH + lc * 16) = kA; *(LAS u32x4*)(K0 + 64 * KPITCH + lr * VPITCH + lc * 16) = vA;
            *(LAS u32x4*)(K1 + lr * KPITCH + lc * 16) = kB; *(LAS u32x4*)(K1 + 64 * KPITCH + lr * VPITCH + lc * 16) = vB;
            __syncthreads();
            ATT_LOAD(kA, vA); ATT_LOAD(kB, vB);
            ATT_STEP(K0, T); ATT_STEP(K1, T + 1);
        }
#undef ATT_STEP
        const size_t qrow0 = (size_t)b * SEQ + c * 64 + qh * 32 + i;
#pragma unroll
        for (int qa = 0; qa < 2; ++qa) {
            const float inv = 1.0f / xrow_sum(l_i[qa]);
#pragma unroll
            for (int dt = 0; dt < 4; ++dt) { u32x2 w; w.x = pk2(acc[qa][dt][0] * inv, acc[qa][dt][1] * inv); w.y = pk2(acc[qa][dt][2] * inv, acc[qa][dt][3] * inv);
                *(u32x2*)(O + (qrow0 + qa * 16) * DM + head * 64 + dt * 16 + g * 4) = w; }
        }
#pragma unroll
        for (int qa = 0; qa < 2; ++qa)
#pragma unroll
            for (int ks = 0; ks < 2; ++ks) qf[qa][ks] = qn[qa][ks];
    }
    __syncthreads();
#undef ATT_LOAD
#undef ATT_QLOAD
#undef ATT_B
#undef ATT_C0
#undef ATT_T0
}

#define XB_TMO      128
#define XB_XCNT(j)  (256  + 64 * (j))
#define XB_XSUB(j)  (1280 + 64 * (j))
#define XB_XGEN(j)  (2304 + 64 * (j))
#define XB_TOP      3328
#define XB_TOPGEN   3392
#define XCD_BAR_WORDS 3456
#define XB_SPIN_CAP (1u << 18)

__device__ __forceinline__ unsigned xb_ld(unsigned* p)              { return __hip_atomic_load(p, __ATOMIC_RELAXED, __HIP_MEMORY_SCOPE_AGENT); }
__device__ __forceinline__ unsigned xb_add(unsigned* p, unsigned v) { return __hip_atomic_fetch_add(p, v, __ATOMIC_RELAXED, __HIP_MEMORY_SCOPE_AGENT); }
__device__ __forceinline__ unsigned xb_xcc_id() { return (unsigned)__builtin_amdgcn_s_getreg((3 << 11) | 20) & 0xFu; }
#define XB_SPIN(cond, bar) do { unsigned _sp = 0; while (cond) { __builtin_amdgcn_s_sleep(1); \
    if ((++_sp & 255u) == 0u) { if (xb_ld(&(bar)[XB_TMO])) break; if (_sp > XB_SPIN_CAP) { atomicAdd(&(bar)[XB_TMO], 1u); break; } } } } while (0)

struct XcdBarrier {
    unsigned* bar; unsigned x;
    volatile LAS unsigned* st;
};

__device__ __forceinline__ XcdBarrier xcd_barrier_post(unsigned* bar, volatile LAS unsigned* st) {
    XcdBarrier b; b.bar = bar; b.x = xb_xcc_id(); b.st = st;
    if (threadIdx.x == 0) (void)xb_add(&bar[XB_XCNT(b.x)], 1u);
    return b;
}
__device__ __forceinline__ void xcd_barrier_complete(unsigned* bar, unsigned x, unsigned& nloc, unsigned& nx) {
    const unsigned G = gridDim.x * gridDim.y * gridDim.z;
    unsigned sum, cnt, mine, sp = 0u;
    for (;;) {
        sum = 0u; cnt = 0u; mine = 0u;
#pragma unroll
        for (unsigned j = 0; j < 16; ++j) { const unsigned c = xb_ld(&bar[XB_XCNT(j)]); sum += c; cnt += (c > 0u) ? 1u : 0u; mine = (j == x) ? c : mine; }
        if (sum == G) break;
        __builtin_amdgcn_s_sleep(1);
        if ((++sp & 255u) == 0u) { if (xb_ld(&bar[XB_TMO])) break; if (sp > XB_SPIN_CAP) { atomicAdd(&bar[XB_TMO], 1u); break; } }
    }
    nloc = mine > 0u ? mine : 1u; nx = cnt > 0u ? cnt : 1u;
}

__device__ __forceinline__ void xcd_barrier(const XcdBarrier& b) {
    asm volatile("s_waitcnt vmcnt(0)" ::: "memory");
    __syncthreads();
    if (threadIdx.x == 0) {
        unsigned* bar = b.bar;
        __builtin_amdgcn_s_waitcnt(0);
        unsigned nloc = b.st[0], nx = b.st[1];
        if (nloc == 0u) { xcd_barrier_complete(bar, b.x, nloc, nx); b.st[0] = nloc; b.st[1] = nx; }
        const unsigned old = xb_add(&bar[XB_XSUB(b.x)], 1u);
        const unsigned gen = old / nloc;
        if (old + 1u == (gen + 1u) * nloc) {
            __builtin_amdgcn_fence(__ATOMIC_RELEASE, "agent");
            asm volatile("s_waitcnt vmcnt(0)" ::: "memory");
            const unsigned og = xb_add(&bar[XB_TOP], 1u);
            const unsigned tg = og / nx;
            if (og + 1u == (tg + 1u) * nx) xb_add(&bar[XB_TOPGEN], 1u);
            else XB_SPIN(xb_ld(&bar[XB_TOPGEN]) == tg, bar);
            __builtin_amdgcn_fence(__ATOMIC_ACQUIRE, "agent");
            xb_add(&bar[XB_XGEN(b.x)], 1u);
            asm volatile("s_waitcnt vmcnt(0)" ::: "memory");
        } else {
            XB_SPIN(xb_ld(&bar[XB_XGEN(b.x)]) == gen, bar);
            __builtin_amdgcn_fence(__ATOMIC_ACQUIRE, "agent");
            asm volatile("s_waitcnt vmcnt(0)" ::: "memory");
        }
    }
    __syncthreads();
}

__global__ void __launch_bounds__(NTHR, 2) fwd_megakernel(Params P) {
    extern __shared__ __attribute__((aligned(16))) unsigned char lds_raw[];
    const ldsp lds = (ldsp)lds_raw;
    cg::grid_group grid = cg::this_grid();
    const int tid0 = threadIdx.x;
    const int G = gridDim.x, bx = blockIdx.x;
    const int vcu = (G % 8 == 0) ? (bx % 8) * (G / 8) + bx / 8 : bx;
    unsigned char* ws = P.ws;
    float* ssq = (float*)(ws + WS_SSQ);
    const float* rot = (const float*)(ws + WS_ROT);
    bf16* Wb = (bf16*)(ws + WS_W);
    bf16* XB = (bf16*)(ws + WS_XB);
    float* TS = (float*)(ws + WS_KV);
    bf16* BIG = (bf16*)(ws + WS_BIG);
    bf16* Z = BIG; bf16* CAT = BIG + (size_t)MTOK * ABW;
    bf16* QKV = BIG; bf16* OB = BIG + (size_t)MTOK * QKVW;
    bf16* HB = BIG;
    const int lo = P.ph_lo, hi = P.ph_hi;
    int ph = 0;
    volatile LAS unsigned* BST = (volatile LAS unsigned*)(lds + LDS_BYTES - 64);
    if (tid0 == 0) { BST[0] = 0u; BST[1] = 0u; }
    __syncthreads();
    unsigned* barw = (unsigned*)ws;
    XcdBarrier xbar; xbar.bar = barw; xbar.x = 0; xbar.st = BST;
#ifndef PH_MASK
#define PH_MASK 0xffff
#endif
#ifndef DUP_MASK
#define DUP_MASK 0
#endif
#define PHASE_BEGIN_K(k) if (((PH_MASK >> (k)) & 1) && ph >= lo && ph < hi) { for (int rep_ = 0; rep_ < (((DUP_MASK >> (k)) & 1) ? 2 : 1); ++rep_) { int tid = tid0; asm volatile("" : "+v"(tid)); const int lane = tid & 63, wave = __builtin_amdgcn_readfirstlane(tid >> 6); (void)lane; (void)wave;
#define PHASE_END   if (ph + 1 < hi) { if (ph == 0) { asm volatile("s_waitcnt vmcnt(0) lgkmcnt(0)" ::: "memory"); grid.sync(); __builtin_amdgcn_fence(__ATOMIC_ACQUIRE, "agent"); asm volatile("s_waitcnt vmcnt(0)" ::: "memory"); \
            xbar = xcd_barrier_post(barw, BST); } else xcd_barrier(xbar); } } } ++ph;

    PHASE_BEGIN_K(0) if (bx == 0) { for (int k_ = tid; k_ < 4096; k_ += NTHR) barw[k_] = 0u; } prologue(P, lds, tid, wave, lane, vcu, G); PHASE_END

    for (int L = 0; L < DEPTH; ++L) {
        const int li = L >> 1;
        if ((L & 1) == 0) {
            const bf16* Wint = Wb + (W_EVEN + (size_t)li * 8 * MiB) / 2; const bf16* Woutt = Wint + (5 * MiB) / 2; const bf16* WpT = Wint + (7 * MiB) / 2;
            PHASE_BEGIN_K(1)
                pg8::Gemm g{XB, Wint, MTOK, ABW, DM}; pg8::StaticOrder S; S.init(MTOK, ABW, G, bx);
                EpiProj<0> E{Z, ABW, ssq, rot};
                pg8::gemm_phase<EpiProj<0>, pg8::StaticOrder, true, true, true>(lds, g, S, E);
            PHASE_END
            PHASE_BEGIN_K(2)
                if (G == 256) retA_pool_phase(lds, Z, TS, WpT, P.ab_pool_scale + li * 512, CAT, vcu, tid, wave, lane);
                else { retA_phase(lds, Z, TS, vcu, G, tid, wave, lane); pool_phase(lds, Z, WpT, P.ab_pool_scale + li * 512, CAT, vcu, G, tid, wave, lane); }
            PHASE_END
            PHASE_BEGIN_K(4)
                retB_phase(lds, Z, TS, P.ab_gn_gain + li * 512, CAT, vcu, G, tid, wave, lane);
            PHASE_END
            PHASE_BEGIN_K(5)
                pg8::Gemm g{CAT, Woutt, MTOK, DM, DM}; pg8::StaticOrder S; S.init(MTOK, DM, G, bx);
                EpiRes E{(L == 0) ? P.x : (const float*)nullptr, (float*)nullptr, XB, ssq + (size_t)MTOK * 16, (const float*)nullptr};
                pg8::gemm_phase<EpiRes, pg8::StaticOrder, true, true>(lds, g, S, E);
            PHASE_END
        } else {
            const bf16* Wqkvt = Wb + (W_ODD + (size_t)li * 8 * MiB) / 2; const bf16* Wot = Wqkvt + (6 * MiB) / 2;
            PHASE_BEGIN_K(6)
                pg8::Gemm g{XB, Wqkvt, MTOK, QKVW, DM}; pg8::StaticOrder S; S.init(MTOK, QKVW, G, bx);
                EpiProj<2> E{QKV, QKVW, ssq, rot};
                pg8::gemm_phase<EpiProj<2>, pg8::StaticOrder, true, true, true>(lds, g, S, E);
            PHASE_END
            PHASE_BEGIN_K(7)
                attn_phase(lds, QKV, P.c_rel_bias + li * 16 * 257, OB, vcu, G, tid, wave, lane);
            PHASE_END
            PHASE_BEGIN_K(8)
                pg8::Gemm g{OB, Wot, MTOK, DM, DM}; pg8::StaticOrder S; S.init(MTOK, DM, G, bx);
                EpiRes E{(L == 0) ? P.x : (const float*)nullptr, (float*)nullptr, XB, ssq + (size_t)MTOK * 16, (const float*)nullptr};
                pg8::gemm_phase<EpiRes, pg8::StaticOrder, true, true>(lds, g, S, E);
            PHASE_END
        }
        const bf16* W1t = Wb + (W_FFN + (size_t)L * 16 * MiB) / 2; const bf16* W2t = W1t + (8 * MiB) / 2;
        PHASE_BEGIN_K(9)
            pg8::Gemm g{XB, W1t, MTOK, FF, DM}; pg8::StaticOrder S; S.init(MTOK, FF, G, bx);
            EpiProj<1> E{HB, FF, ssq + (size_t)MTOK * 16, rot};
            pg8::gemm_phase<EpiProj<1>, pg8::StaticOrder, true, true, true>(lds, g, S, E);
        PHASE_END
        PHASE_BEGIN_K(10)
            pg8::Gemm g{HB, W2t, MTOK, DM, FF}; pg8::StaticOrder S; S.init(MTOK, DM, G, bx);
            EpiRes E{(const float*)nullptr, (L == DEPTH - 1) ? P.out : (float*)nullptr, XB, ssq, ssq + (size_t)MTOK * 16};
            pg8::gemm_phase<EpiRes, pg8::StaticOrder, true, true, true>(lds, g, S, E);
        PHASE_END
    }
    PHASE_BEGIN_K(11)
        const int gw = vcu * NWAVES + wave, NGW = G * NWAVES;
        const f32x4* gr = (const f32x4*)P.final_norm + lane;
        f32x4 gv[4];
#pragma unroll
        for (int j = 0; j < 4; ++j) gv[j] = gr[64 * j];
        for (int m0 = gw * 4; m0 < MTOK; m0 += NGW * 4) {
            f32x4 v[4][4]; float rs[4];
#pragma unroll
            for (int r = 0; r < 4; ++r) { const f32x4* xr = (const f32x4*)(P.out + (size_t)(m0 + r) * DM) + lane; rs[r] = row_rstd(ssq, (size_t)(m0 + r));
#pragma unroll
                for (int j = 0; j < 4; ++j) v[r][j] = xr[64 * j]; }
#pragma unroll
            for (int r = 0; r < 4; ++r) { f32x4* xo = (f32x4*)(P.out + (size_t)(m0 + r) * DM) + lane;
#pragma unroll
                for (int j = 0; j < 4; ++j) xo[64 * j] = v[r][j] * rs[r] * gv[j]; }
        }
    PHASE_END
#undef PHASE_BEGIN_K
#undef PHASE_END
}

extern "C" void kernel_launch(void* const* d_in, const int* in_sizes, int n_in, void* d_out, int out_size, void* d_ws, size_t ws_size, hipStream_t stream) {
    static int grid = 0;
    if (grid == 0) {
        if (n_in != 14 || in_sizes[0] != MTOK * DM || out_size != MTOK * DM || ws_size < WS_END) {
            fprintf(stderr, "kernel_launch: unexpected shapes/workspace: n_in %d in0 %d out %d ws %zu (need %zu)\n", n_in, n_in > 0 ? in_sizes[0] : -1, out_size, ws_size, (size_t)WS_END); grid = -1; return; }
        int dev = 0, cus = 0, per_cu = 0;
        if (hipGetDevice(&dev) != hipSuccess || hipDeviceGetAttribute(&cus, hipDeviceAttributeMultiprocessorCount, dev) != hipSuccess) { grid = -1; return; }
        if (hipFuncSetAttribute((const void*)fwd_megakernel, hipFuncAttributeMaxDynamicSharedMemorySize, LDS_BYTES) != hipSuccess) { fprintf(stderr, "kernel_launch: hipFuncSetAttribute failed\n"); grid = -1; return; }
        if (hipOccupancyMaxActiveBlocksPerMultiprocessor(&per_cu, (const void*)fwd_megakernel, NTHR, LDS_BYTES) != hipSuccess || per_cu < 1) { fprintf(stderr, "kernel_launch: occupancy query says %d\n", per_cu); per_cu = 1; }
        (void)hipGetLastError();
        grid = cus;
    }
    if (grid < 0) return;
    Params p{};
    p.x = (const float*)d_in[0]; p.mix_norm = (const float*)d_in[1]; p.ffn_norm = (const float*)d_in[2]; p.w_ffn_in = (const float*)d_in[3]; p.w_ffn_out = (const float*)d_in[4];
    p.ab_w_in = (const float*)d_in[5]; p.ab_gn_gain = (const float*)d_in[6]; p.ab_w_pool = (const float*)d_in[7]; p.ab_pool_scale = (const float*)d_in[8]; p.ab_w_out = (const float*)d_in[9];
    p.c_w_qkv = (const float*)d_in[10]; p.c_rel_bias = (const float*)d_in[11]; p.c_w_out = (const float*)d_in[12]; p.final_norm = (const float*)d_in[13];
    p.out = (float*)d_out; p.ws = (unsigned char*)d_ws; p.ph_lo = 0; p.ph_hi = 1 << 20;
    void* args[] = {&p};
    const hipError_t e = hipLaunchCooperativeKernel((const void*)fwd_megakernel, dim3(grid), dim3(NTHR), args, LDS_BYTES, stream);
    if (e != hipSuccess) fprintf(stderr, "kernel_launch: cooperative launch failed: %s (grid %d)\n", hipGetErrorString(e), grid);
}
```

```cpp
#include <hip/hip_runtime.h>
#include <hip/hip_cooperative_groups.h>
#include <cstdio>
#include <cstdint>
#include <cmath>
namespace cg = cooperative_groups;
namespace pg8 {
#define PG8_LAS __attribute__((address_space(3)))
typedef unsigned short bf16_t;
typedef short bf16x8 __attribute__((ext_vector_type(8)));
typedef float f32x4 __attribute__((ext_vector_type(4)));
typedef unsigned u32x4 __attribute__((ext_vector_type(4)));
constexpr int BM = 256, BK = 64, HALF = 128, HTB = HALF * BK * 2  , STAGE_BYTES = 8 * HTB, NXCD = 8, WGM = 8;

__host__ __device__ __forceinline__ int lds_byte(int r, int c) { const int st = (r >> 4) * 2 + (c >> 5), rr = r & 15, cc = c & 31, ob = rr * 64 + cc * 2; return st * 1024 + (ob ^ (((ob >> 9) & 1) << 5)); }
__host__ __device__ __forceinline__ void stage_rc(int b, int& R, int& C) { const int st = b / 1024, sb = b % 1024, swz = sb ^ (((sb >> 9) & 1) << 5); R = (st >> 1) * 16 + swz / 64; C = (st & 1) * 32 + (swz % 64) / 2; }
__host__ __device__ __forceinline__ int perm32(int rho) { const int n = rho >> 4, i = rho & 15; return 8 * (i >> 2) + 4 * n + (i & 3); }

struct Unit { int pm, pn; };
struct Gemm { const bf16_t* A; const bf16_t* Bt; int M, N, K; };

struct StaticOrder {
    int nM, nN, nwg, G, c;
    __host__ __device__ void init(int M, int N, int G_, int c_) { nM = M / BM; nN = N / BM; nwg = nM * nN; G = G_; c = c_; }
    __host__ __device__ bool next(int i, Unit& u) const {
        const long L = (long)i * G + c; if (L >= nwg) return false;
        int wgid = (int)L; { const int q = nwg / NXCD, r = nwg % NXCD, xcd = wgid % NXCD, off = wgid / NXCD; wgid = (xcd < r ? xcd * (q + 1) : r * (q + 1) + (xcd - r) * q) + off; }
        const int nig = WGM * nN, gid = wgid / nig, fm = gid * WGM, gsz = (nM - fm) < WGM ? (nM - fm) : WGM;
        u.pm = fm + ((wgid % nig) % gsz); u.pn = (wgid % nig) / gsz; return true;
    }
    __device__ __forceinline__ void a_ready(const Unit&) const {}
    __device__ __forceinline__ void done(const Unit&) const {}
};

template <class Epi, class Sched, bool ALIGN_EPI = false, bool SP2 = false, bool A_TILED = false>
__device__ __forceinline__ void gemm_phase(PG8_LAS unsigned char* lds, const Gemm g, const Sched& S, const Epi& E) {
    int tid = threadIdx.x; asm volatile("" : "+v"(tid));
    const int wid = __builtin_amdgcn_readfirstlane(tid >> 6), lane = tid & 63, wr = wid >> 2, wc = wid & 3, fr = lane & 15, fq = lane >> 4;
    const int K = g.K, nt = K / BK;
    unsigned voffA[2], voffB[2];
#pragma unroll
    for (int i = 0; i < 2; ++i) { int R, C; stage_rc(tid * 16 + i * 8192, R, C); const int Rb = Epi::PERM ? ((R & ~31) + perm32(R & 31)) : R;
        voffA[i] = A_TILED ? (unsigned)(((R >> 4) * (K >> 5) + (C >> 5)) * 1024 + ((R & 15) * 32 + (C & 31)) * 2) : (unsigned)(R * K + C) * 2u; voffB[i] = (unsigned)(Rb * K + C) * 2u; }
    const size_t kstep = (size_t)(BK * 2);
    const size_t kstepA = A_TILED ? (size_t)2048 : kstep;
    const size_t hstep = (size_t)HALF * K * 2;
    const size_t tstep = 2 * hstep;
    const unsigned ldsw = (unsigned)wid * 1024u;
    const int aoff = lds_byte(wr * 64 + fr, fq * 8), boff = lds_byte(wc * 32 + fr, fq * 8);
#define PG8_SA(b, h) (((b) * 2 + (h)) * HTB)
#define PG8_SB(b, h) ((4 + (b) * 2 + (h)) * HTB)
#define PG8_STAGE(bufoff, gbase, voff) do { _Pragma("unroll") for (int _i = 0; _i < 2; ++_i) \
        __builtin_amdgcn_global_load_lds((const unsigned*)((const char*)(gbase) + (voff)[_i]), (PG8_LAS unsigned*)(lds + (bufoff) + ldsw + _i * 8192), 16, 0, 0); } while (0)
#define PG8_LDA(dst, b, h) do { _Pragma("unroll") for (int m = 0; m < 4; ++m) _Pragma("unroll") for (int k = 0; k < 2; ++k) dst[m][k] = *(const PG8_LAS bf16x8*)(lds + PG8_SA(b, h) + aoff + m * 2048 + k * 1024); } while (0)
#define PG8_LDB(dst, b, h) do { _Pragma("unroll") for (int n = 0; n < 2; ++n) _Pragma("unroll") for (int k = 0; k < 2; ++k) dst[n][k] = *(const PG8_LAS bf16x8*)(lds + PG8_SB(b, h) + boff + n * 2048 + k * 1024); } while (0)
#define PG8_MMA(ai, bj, At, Bt) do { __builtin_amdgcn_s_setprio(1); _Pragma("unroll") for (int m = 0; m < 4; ++m) _Pragma("unroll") for (int n = 0; n < 2; ++n) _Pragma("unroll") for (int k = 0; k < 2; ++k) \
        acc[ai][bj][m][n] = __builtin_amdgcn_mfma_f32_16x16x32_bf16(Bt[n][k], At[m][k], acc[ai][bj][m][n], 0, 0, 0); __builtin_amdgcn_s_setprio(0); } while (0)
#define PG8_WAIT_V(n) asm volatile("s_waitcnt vmcnt(" #n ")" ::: "memory")
#define PG8_WAIT_L(n) asm volatile("s_waitcnt lgkmcnt(" #n ")" ::: "memory")
#define PG8_BAR __builtin_amdgcn_s_barrier()
#define PG8_SCHED __builtin_amdgcn_sched_barrier(0)
    Unit cur, nxt; int ui = 0;
    if (!S.next(0, cur)) return;
    f32x4 acc[2][2][4][2];
#pragma unroll
    for (int a = 0; a < 2; ++a)
#pragma unroll
        for (int b = 0; b < 2; ++b)
#pragma unroll
            for (int m = 0; m < 4; ++m)
#pragma unroll
                for (int n = 0; n < 2; ++n) acc[a][b][m][n] = (f32x4){0.f, 0.f, 0.f, 0.f};
    bf16x8 At[4][2], B0[2][2], B1[2][2];
    const char* cA = (const char*)g.A + (size_t)cur.pm * tstep; const char* cB = (const char*)g.Bt + (size_t)cur.pn * tstep;
    S.a_ready(cur);
    if constexpr (SP2) {
        PG8_STAGE(PG8_SB(0, 0), cB, voffB); PG8_STAGE(PG8_SB(0, 1), cB + hstep, voffB); PG8_STAGE(PG8_SA(0, 0), cA, voffA); PG8_STAGE(PG8_SA(0, 1), cA + hstep, voffA);
        if (wr == 1) PG8_BAR;
        PG8_WAIT_V(2); PG8_BAR;
        PG8_STAGE(PG8_SB(1, 0), cB + kstep, voffB); PG8_STAGE(PG8_SA(1, 0), cA + kstepA, voffA); PG8_STAGE(PG8_SB(1, 1), cB + hstep + kstep, voffB);
        PG8_WAIT_V(6); PG8_BAR;
    } else {
        PG8_STAGE(PG8_SB(0, 0), cB, voffB); PG8_STAGE(PG8_SA(0, 0), cA, voffA); PG8_STAGE(PG8_SB(0, 1), cB + hstep, voffB); PG8_STAGE(PG8_SA(0, 1), cA + hstep, voffA);
        if (wr == 1) PG8_BAR;
        PG8_WAIT_V(4); PG8_BAR;
        PG8_STAGE(PG8_SB(1, 0), cB + kstep, voffB); PG8_STAGE(PG8_SA(1, 0), cA + kstepA, voffA); PG8_STAGE(PG8_SB(1, 1), cB + hstep + kstep, voffB);
        PG8_WAIT_V(6); PG8_BAR;
    }
    for (;;) {
        const bool has_next = S.next(ui + 1, nxt);
        const char* nA = has_next ? (const char*)g.A + (size_t)nxt.pm * tstep : cA; const char* nB = has_next ? (const char*)g.Bt + (size_t)nxt.pn * tstep : cB;
        for (int t = 0; t < nt; t += 2) {
            const bool last = (t == nt - 2);
            const char* a1 = cA + (size_t)(t + 1) * kstepA;
            const char* a2 = last ? nA : cA + (size_t)(t + 2) * kstepA; const char* b2 = last ? nB : cB + (size_t)(t + 2) * kstep;
            const char* a3 = a2 + kstepA; const char* b3 = b2 + kstep;
            if (last && has_next) S.a_ready(nxt);
            if constexpr (SP2) {
            PG8_LDB(B0, 0, 0); PG8_LDB(B1, 0, 1); PG8_SCHED; PG8_LDA(At, 0, 0); PG8_STAGE(PG8_SA(1, 1), a1 + hstep, voffA);
            PG8_WAIT_V(8); PG8_WAIT_L(0); PG8_BAR; PG8_MMA(0, 0, At, B0); PG8_MMA(0, 1, At, B1); PG8_BAR; PG8_SCHED;
            PG8_LDA(At, 0, 1); PG8_STAGE(PG8_SB(0, 0), b2, voffB); PG8_STAGE(PG8_SB(0, 1), b2 + hstep, voffB); PG8_STAGE(PG8_SA(0, 0), a2, voffA);
            PG8_WAIT_V(8); PG8_WAIT_L(0); PG8_BAR; PG8_MMA(1, 0, At, B0); PG8_MMA(1, 1, At, B1); PG8_BAR; PG8_SCHED;
            PG8_LDB(B0, 1, 0); PG8_LDB(B1, 1, 1); PG8_SCHED; PG8_LDA(At, 1, 0); PG8_STAGE(PG8_SA(0, 1), a2 + hstep, voffA);
            PG8_WAIT_V(8); PG8_WAIT_L(0); PG8_BAR; PG8_MMA(0, 0, At, B0); PG8_MMA(0, 1, At, B1); PG8_BAR; PG8_SCHED;
            PG8_LDA(At, 1, 1); PG8_STAGE(PG8_SB(1, 0), b3, voffB); PG8_STAGE(PG8_SB(1, 1), b3 + hstep, voffB); PG8_STAGE(PG8_SA(1, 0), a3, voffA);
            PG8_WAIT_V(8); PG8_WAIT_L(0); PG8_BAR; PG8_MMA(1, 0, At, B0); PG8_MMA(1, 1, At, B1); PG8_BAR; PG8_SCHED;
            } else {
            PG8_LDB(B0, 0, 0); PG8_SCHED; PG8_LDA(At, 0, 0); PG8_STAGE(PG8_SA(1, 1), a1 + hstep, voffA);
            PG8_WAIT_L(8); PG8_BAR; PG8_WAIT_L(0); PG8_MMA(0, 0, At, B0); PG8_BAR; PG8_SCHED;
            PG8_LDB(B1, 0, 1); PG8_STAGE(PG8_SB(0, 0), b2, voffB);
            PG8_BAR; PG8_WAIT_L(0); PG8_MMA(0, 1, At, B1); PG8_BAR;
            PG8_LDA(At, 0, 1); PG8_STAGE(PG8_SA(0, 0), a2, voffA);
            PG8_BAR; PG8_WAIT_L(0); PG8_MMA(1, 0, At, B0); PG8_BAR; PG8_SCHED;
            PG8_STAGE(PG8_SB(0, 1), b2 + hstep, voffB);
            PG8_WAIT_V(6); PG8_BAR; PG8_MMA(1, 1, At, B1); PG8_BAR;
            PG8_LDB(B0, 1, 0); PG8_SCHED; PG8_LDA(At, 1, 0); PG8_STAGE(PG8_SA(0, 1), a2 + hstep, voffA);
            PG8_WAIT_L(8); PG8_BAR; PG8_WAIT_L(0); PG8_MMA(0, 0, At, B0); PG8_BAR; PG8_SCHED;
            PG8_LDB(B1, 1, 1); PG8_STAGE(PG8_SB(1, 0), b3, voffB);
            PG8_BAR; PG8_WAIT_L(0); PG8_MMA(0, 1, At, B1); PG8_BAR;
            PG8_LDA(At, 1, 1); PG8_STAGE(PG8_SA(1, 0), a3, voffA);
            PG8_BAR; PG8_WAIT_L(0); PG8_MMA(1, 0, At, B0); PG8_BAR; PG8_SCHED;
            PG8_STAGE(PG8_SB(1, 1), b3 + hstep, voffB);
            PG8_WAIT_V(6); PG8_BAR; PG8_MMA(1, 1, At, B1); PG8_BAR;
            }
        }
        if constexpr (ALIGN_EPI) { if (wr == 0) PG8_BAR; }
        if constexpr (!Epi::AFTER_DRAIN) { E(acc, cur, wr, wc, fr, fq); S.done(cur); }
        if (!has_next) break;
#pragma unroll
        for (int a = 0; a < 2; ++a)
#pragma unroll
            for (int b = 0; b < 2; ++b)
#pragma unroll
                for (int m = 0; m < 4; ++m)
#pragma unroll
                    for (int n = 0; n < 2; ++n) acc[a][b][m][n] = (f32x4){0.f, 0.f, 0.f, 0.f};
        cur = nxt; cA = nA; cB = nB; ++ui;
        if constexpr (ALIGN_EPI) { if (wr == 1) PG8_BAR; }
    }
    PG8_WAIT_V(0);
    if constexpr (!ALIGN_EPI) { if (wr == 0) PG8_BAR; }
    PG8_BAR;
    if constexpr (Epi::AFTER_DRAIN) { E.fused(acc, cur, wr, wc, fr, fq, lds, wid, lane); S.done(cur); }
#undef PG8_SA
#undef PG8_SB
#undef PG8_STAGE
#undef PG8_LDA
#undef PG8_LDB
#undef PG8_MMA
#undef PG8_WAIT_V
#undef PG8_WAIT_L
#undef PG8_BAR
#undef PG8_SCHED
}
}

#define LAS __attribute__((address_space(3)))
typedef unsigned short bf16;
typedef short bf16x8 __attribute__((ext_vector_type(8)));
typedef short s16x4 __attribute__((ext_vector_type(4)));
typedef short v4i16_t __attribute__((ext_vector_type(4)));
typedef float f32x4 __attribute__((ext_vector_type(4)));
typedef unsigned u32x4 __attribute__((ext_vector_type(4)));
typedef unsigned u32x2 __attribute__((ext_vector_type(2)));
typedef LAS unsigned char* ldsp;

constexpr int BATCH = 8, SEQ = 8192, DM = 1024, DEPTH = 4, CHUNK = 64, MTOK = BATCH * SEQ, FF = 4096, NCH = SEQ / CHUNK;
constexpr int ABW = 2560, QKVW = 3072;
constexpr float RMS_EPS = 1e-6f, GN_EPS = 1e-5f, LOG2E = 1.4426950408889634f;
constexpr float QC2 = 0.125f * LOG2E;
constexpr int NWAVES = 8, NTHR = 512;
constexpr int LDS_BYTES = 147456;
constexpr int PITCH = 272;

constexpr size_t MiB = 1u << 20;
constexpr size_t WS_SSQ = 1000 * MiB;
constexpr size_t WS_ROT = 4 * MiB;
constexpr size_t WS_W = 8 * MiB;
constexpr size_t W_FFN = 0;
constexpr size_t W_EVEN = 64 * MiB;
constexpr size_t W_ODD = 80 * MiB;
constexpr size_t WS_XB = 104 * MiB;
constexpr size_t WS_KV = 232 * MiB;
constexpr size_t WS_BIG = 488 * MiB;
constexpr size_t WS_END = 1008 * MiB;

__device__ __forceinline__ unsigned f2bf(float f) { unsigned u = __builtin_bit_cast(unsigned, f); return (u + 0x7fffu + ((u >> 16) & 1u)) >> 16; }
typedef float f32x2_t __attribute__((ext_vector_type(2))); typedef __bf16 bf16x2_t __attribute__((ext_vector_type(2)));
__device__ __forceinline__ unsigned pk2(float lo, float hi) { const f32x2_t v = {lo, hi}; const bf16x2_t b = __builtin_convertvector(v, bf16x2_t); return __builtin_bit_cast(unsigned, b); }
__device__ __forceinline__ float bflo(unsigned u) { return __builtin_bit_cast(float, u << 16); }
__device__ __forceinline__ float bfhi(unsigned u) { return __builtin_bit_cast(float, u & 0xffff0000u); }
__device__ __forceinline__ bf16x8 lds_rd16(ldsp p) { return *(const LAS bf16x8*)p; }
__device__ __forceinline__ s16x4 lds_tr(ldsp p) { return __builtin_bit_cast(s16x4, __builtin_amdgcn_ds_read_tr16_b64_v4i16((LAS v4i16_t*)p)); }
__device__ __forceinline__ bf16x8 trfrag(ldsp p, int second_off) { const s16x4 lo = lds_tr(p), hi = lds_tr(p + second_off); return (bf16x8){lo[0], lo[1], lo[2], lo[3], hi[0], hi[1], hi[2], hi[3]}; }
__device__ __forceinline__ bf16x8 pack8(f32x4 a, f32x4 b) { u32x4 w; w.x = pk2(a[0], a[1]); w.y = pk2(a[2], a[3]); w.z = pk2(b[0], b[1]); w.w = pk2(b[2], b[3]); return __builtin_bit_cast(bf16x8, w); }
#define EX2(x) __builtin_amdgcn_exp2f(x)
#define MFMA16(a, b, c) __builtin_amdgcn_mfma_f32_16x16x32_bf16((a), (b), (c), 0, 0, 0)
__device__ __forceinline__ float wave_sum(float v) {
#pragma unroll
    for (int o = 1; o < 64; o <<= 1) v += __shfl_xor(v, o);
    return v;
}
__device__ __forceinline__ void swap16(float& a, float& b) { asm("s_nop 1\n\tv_permlane16_swap_b32 %0, %1" : "+v"(a), "+v"(b)); }
__device__ __forceinline__ void swap32(float& a, float& b) { asm("s_nop 1\n\tv_permlane32_swap_b32 %0, %1" : "+v"(a), "+v"(b)); }
__device__ __forceinline__ float xrow_sum(float v) {
    float a = v, b = v; swap16(a, b); v = a + b;
    a = v; b = v; swap32(a, b); return a + b;
}
__device__ __forceinline__ float xrow_max(float v) {
    float a = v, b = v; swap16(a, b); v = fmaxf(a, b);
    a = v; b = v; swap32(a, b); return fmaxf(a, b);
}
__device__ __forceinline__ float head_lg(int h) { asm volatile("" : "+s"(h)); return log2f(1.0f - exp2f(-5.0f - (float)h)); }

__device__ __forceinline__ float row_rstd(const float* ssq, size_t row) {
    const f32x4* p = (const f32x4*)(ssq + row * 16);
    const f32x4 a = p[0], b = p[1], c = p[2], d = p[3];
    const float s = (((a[0] + a[1]) + (a[2] + a[3])) + ((b[0] + b[1]) + (b[2] + b[3]))) + (((c[0] + c[1]) + (c[2] + c[3])) + ((d[0] + d[1]) + (d[2] + d[3])));
    return rsqrtf(s * (1.0f / DM) + RMS_EPS);
}
__device__ __forceinline__ size_t z_off(int row, int col) { return ((size_t)(row >> 4) * (ABW >> 5) + (col >> 5)) * 512 + (row & 15) * 32 + (col & 31); }
__device__ __forceinline__ size_t xb_off(int row, int col) { return ((size_t)(row >> 4) * (DM >> 5) + (col >> 5)) * 512 + (row & 15) * 32 + (col & 31); }
template <int MODE> struct EpiProj {
    static constexpr bool PERM = true, AFTER_DRAIN = false;
    bf16* O; int ldc; const float* ssq; const float* rot;
    __device__ __forceinline__ void operator()(const pg8::f32x4 (&acc)[2][2][4][2], const pg8::Unit& u, int wr, int wc, int fr, int fq) const {
        const int row0 = u.pm * 256 + wr * 64 + fr, colt = u.pn * 256 + wc * 32 + 8 * fq;
        float rstd[8];
        if (MODE == 1) {
#pragma unroll
            for (int r8 = 0; r8 < 8; ++r8) rstd[r8] = 1.0f;
        } else {
            f32x4 pr[8];
#pragma unroll
            for (int r8 = 0; r8 < 8; ++r8) pr[r8] = *(const f32x4*)(ssq + (size_t)(row0 + (r8 >> 2) * 128 + (r8 & 3) * 16) * 16 + 4 * fq);
#pragma unroll
            for (int r8 = 0; r8 < 8; ++r8) { const float s4 = xrow_sum((pr[r8][0] + pr[r8][1]) + (pr[r8][2] + pr[r8][3])); rstd[r8] = rsqrtf(s4 * (1.0f / DM) + RMS_EPS); }
        }
        if (MODE == 0 && u.pn < 4) {
            f32x4 rc[2][2][2];
            const int pairi = (colt & 127) >> 1;
#define EPI_ROT_LOAD(bt, buf) do { _Pragma("unroll") for (int rr = 0; rr < 2; ++rr) { const int r8 = (bt) * 2 + rr; const int pos = (row0 + (r8 >> 2) * 128 + (r8 & 3) * 16) & (SEQ - 1); \
                const f32x4* rp = (const f32x4*)(rot + ((size_t)pos * 64 + pairi) * 2); rc[buf][rr][0] = rp[0]; rc[buf][rr][1] = rp[1]; } } while (0)
            EPI_ROT_LOAD(0, 0);
            const float sc = (u.pn >= 2) ? 0.08838834764831845f : 1.0f;
#pragma unroll
            for (int bt = 0; bt < 4; ++bt) {
                if (bt < 3) EPI_ROT_LOAD(bt + 1, (bt + 1) & 1);
#pragma unroll
                for (int rr = 0; rr < 2; ++rr) { const int r8 = bt * 2 + rr, ai = r8 >> 2, m = r8 & 3; const int row = row0 + ai * 128 + m * 16;
                    const f32x4 c0 = rc[bt & 1][rr][0], c1 = rc[bt & 1][rr][1]; const float rs = rstd[r8] * sc;
#pragma unroll
                    for (int bj = 0; bj < 2; ++bj) {
                        const f32x4 v0 = acc[ai][bj][m][0] * rs, v1 = acc[ai][bj][m][1] * rs;
                        f32x4 r0, r1;
                        r0[0] = v0[0] * c0[0] - v0[1] * c0[1]; r0[1] = v0[0] * c0[1] + v0[1] * c0[0];
                        r0[2] = v0[2] * c0[2] - v0[3] * c0[3]; r0[3] = v0[2] * c0[3] + v0[3] * c0[2];
                        r1[0] = v1[0] * c1[0] - v1[1] * c1[1]; r1[1] = v1[0] * c1[1] + v1[1] * c1[0];
                        r1[2] = v1[2] * c1[2] - v1[3] * c1[3]; r1[3] = v1[2] * c1[3] + v1[3] * c1[2];
                        u32x4 w; w.x = pk2(r0[0], r0[1]); w.y = pk2(r0[2], r0[3]); w.z = pk2(r1[0], r1[1]); w.w = pk2(r1[2], r1[3]);
                        { const int col = colt + bj * 128; *(u32x4*)(O + ((size_t)(row >> 4) * (ldc >> 5) + (col >> 5)) * 512 + (row & 15) * 32 + (col & 31)) = w; }
                    } }
            }
#undef EPI_ROT_LOAD
        } else {
            const float sc = (MODE == 2 && u.pn < 4) ? QC2 : 1.0f;
#pragma unroll
            for (int r8 = 0; r8 < 8; ++r8) { const int ai = r8 >> 2, m = r8 & 3; const int row = row0 + ai * 128 + m * 16; const float rs = rstd[r8] * sc;
#pragma unroll
                for (int bj = 0; bj < 2; ++bj) {
                    f32x4 v0 = acc[ai][bj][m][0] * rs, v1 = acc[ai][bj][m][1] * rs;
                    if (MODE == 1) {
#pragma unroll
                        for (int e = 0; e < 4; ++e) { const float a = fmaxf(v0[e], 0.f), b = fmaxf(v1[e], 0.f); v0[e] = a * a; v1[e] = b * b; }
                    }
                    u32x4 w; w.x = pk2(v0[0], v0[1]); w.y = pk2(v0[2], v0[3]); w.z = pk2(v1[0], v1[1]); w.w = pk2(v1[2], v1[3]);
                    if (true) { const int col = colt + bj * 128;
                        *(u32x4*)(O + ((size_t)(row >> 4) * (ldc >> 5) + (col >> 5)) * 512 + (row & 15) * 32 + (col & 31)) = w; }
                    else *(u32x4*)(O + (size_t)row * ldc + colt + bj * 128) = w;
                } }
        }
    }
};
struct EpiRes {
    static constexpr bool PERM = true, AFTER_DRAIN = false;
    const float* basef; float* out; bf16* xb; float* ssq_next; const float* ssq_scale;
    __device__ __forceinline__ void operator()(const pg8::f32x4 (&acc)[2][2][4][2], const pg8::Unit& u, int wr, int wc, int fr, int fq) const {
        const int row0 = u.pm * 256 + wr * 64 + fr, colt = u.pn * 256 + wc * 32 + 8 * fq;
        if (basef) {
            f32x4 bb[2][2][2];
#define EPI_RES_LOAD(r8_, buf) do { const float* bp = basef + (size_t)(row0 + ((r8_) >> 2) * 128 + ((r8_) & 3) * 16) * DM + colt; \
                _Pragma("unroll") for (int bj = 0; bj < 2; ++bj) { bb[buf][bj][0] = *(const f32x4*)(bp + bj * 128); bb[buf][bj][1] = *(const f32x4*)(bp + bj * 128 + 4); } } while (0)
            EPI_RES_LOAD(0, 0);
#pragma unroll
            for (int r8 = 0; r8 < 8; ++r8) {
                if (r8 < 7) EPI_RES_LOAD(r8 + 1, (r8 + 1) & 1);
                const int ai = r8 >> 2, m = r8 & 3; const int row = row0 + ai * 128 + m * 16;
                float sq = 0.f;
#pragma unroll
                for (int bj = 0; bj < 2; ++bj) {
                    const size_t off = (size_t)row * DM + colt + bj * 128;
                    const f32x4 v0 = acc[ai][bj][m][0] + bb[r8 & 1][bj][0], v1 = acc[ai][bj][m][1] + bb[r8 & 1][bj][1];
                    if (out) { *(f32x4*)(out + off) = v0; *(f32x4*)(out + off + 4) = v1; }
                    u32x4 w; w.x = pk2(v0[0], v0[1]); w.y = pk2(v0[2], v0[3]); w.z = pk2(v1[0], v1[1]); w.w = pk2(v1[2], v1[3]);
                    if (xb) *(u32x4*)(xb + xb_off(row, colt + bj * 128)) = w;
                    sq += (v0[0] * v0[0] + v0[1] * v0[1]) + (v0[2] * v0[2] + v0[3] * v0[3]) + (v1[0] * v1[0] + v1[1] * v1[1]) + (v1[2] * v1[2] + v1[3] * v1[3]);
                }
                sq = xrow_sum(sq);
                if (fq == 0) ssq_next[(size_t)row * 16 + u.pn * 4 + wc] = sq;
            }
#undef EPI_RES_LOAD
        } else {
            float rf[8];
            if (ssq_scale) {
                f32x4 pr[8];
#pragma unroll
                for (int r8 = 0; r8 < 8; ++r8) pr[r8] = *(const f32x4*)(ssq_scale + (size_t)(row0 + (r8 >> 2) * 128 + (r8 & 3) * 16) * 16 + 4 * fq);
#pragma unroll
                for (int r8 = 0; r8 < 8; ++r8) { const float s4 = xrow_sum((pr[r8][0] + pr[r8][1]) + (pr[r8][2] + pr[r8][3])); rf[r8] = 1.0f / (s4 * (1.0f / DM) + RMS_EPS); }
            } else {
#pragma unroll
                for (int r8 = 0; r8 < 8; ++r8) rf[r8] = 1.0f;
            }
            u32x4 bb[2][2][2];
#define EPI_RESB_LOAD(bt, buf) do { _Pragma("unroll") for (int rr = 0; rr < 2; ++rr) { const int r8 = (bt) * 2 + rr; const int br_ = row0 + (r8 >> 2) * 128 + (r8 & 3) * 16; \
                bb[buf][rr][0] = *(const u32x4*)(xb + xb_off(br_, colt)); bb[buf][rr][1] = *(const u32x4*)(xb + xb_off(br_, colt + 128)); } } while (0)
            EPI_RESB_LOAD(0, 0);
#pragma unroll
            for (int bt = 0; bt < 4; ++bt) {
                if (bt < 3) EPI_RESB_LOAD(bt + 1, (bt + 1) & 1);
#pragma unroll
                for (int rr = 0; rr < 2; ++rr) { const int r8 = bt * 2 + rr, ai = r8 >> 2, m = r8 & 3; const int row = row0 + ai * 128 + m * 16;
                    float sq = 0.f;
#pragma unroll
                    for (int bj = 0; bj < 2; ++bj) {
                        const size_t off = (size_t)row * DM + colt + bj * 128; const u32x4 bw = bb[bt & 1][rr][bj];
                        f32x4 v0 = acc[ai][bj][m][0] * rf[r8], v1 = acc[ai][bj][m][1] * rf[r8];
                        v0[0] += bflo(bw.x); v0[1] += bfhi(bw.x); v0[2] += bflo(bw.y); v0[3] += bfhi(bw.y); v1[0] += bflo(bw.z); v1[1] += bfhi(bw.z); v1[2] += bflo(bw.w); v1[3] += bfhi(bw.w);
                        if (out) { *(f32x4*)(out + off) = v0; *(f32x4*)(out + off + 4) = v1; }
                        else { u32x4 w; w.x = pk2(v0[0], v0[1]); w.y = pk2(v0[2], v0[3]); w.z = pk2(v1[0], v1[1]); w.w = pk2(v1[2], v1[3]); *(u32x4*)(xb + xb_off(row, colt + bj * 128)) = w; }
                        sq += (v0[0] * v0[0] + v0[1] * v0[1]) + (v0[2] * v0[2] + v0[3] * v0[3]) + (v1[0] * v1[0] + v1[1] * v1[1]) + (v1[2] * v1[2] + v1[3] * v1[3]);
                    }
                    sq = xrow_sum(sq);
                    if (fq == 0) ssq_next[(size_t)row * 16 + u.pn * 4 + wc] = sq; }
            }
#undef EPI_RESB_LOAD
        }
    }
};
__device__ __forceinline__ void transpose_item(const float* W, int K, int N, int ldw, const float* gain, bf16* WT, LAS float* scr, int item, int lane) {
    const int nblk = N / 32, kb = item / nblk, nb = item % nblk, k0 = 64 * kb, n0 = 32 * nb;
#pragma unroll 8
    for (int i = 0; i < 32; ++i) { const int kk = 2 * i + (lane >> 5); const float gsc = gain ? gain[k0 + kk] : 1.0f; scr[kk * 33 + (lane & 31)] = W[(size_t)(k0 + kk) * ldw + n0 + (lane & 31)] * gsc; }
    asm volatile("s_waitcnt lgkmcnt(0)" ::: "memory");
    const int c = lane & 7;
#pragma unroll
    for (int j = 0; j < 4; ++j) { const int n = (lane >> 3) + 8 * j; const LAS float* s = scr + (8 * c) * 33 + n;
        u32x4 o; o.x = pk2(s[0 * 33], s[1 * 33]); o.y = pk2(s[2 * 33], s[3 * 33]); o.z = pk2(s[4 * 33], s[5 * 33]); o.w = pk2(s[6 * 33], s[7 * 33]);
        *(u32x4*)(WT + (size_t)(n0 + n) * K + k0 + 8 * c) = o; }
    asm volatile("s_waitcnt lgkmcnt(0)" ::: "memory");
}

struct Params {
    const float* x; const float* mix_norm; const float* ffn_norm; const float* w_ffn_in; const float* w_ffn_out;
    const float* ab_w_in; const float* ab_gn_gain; const float* ab_w_pool; const float* ab_pool_scale; const float* ab_w_out;
    const float* c_w_qkv; const float* c_rel_bias; const float* c_w_out; const float* final_norm;
    float* out; unsigned char* ws; int ph_lo, ph_hi;
};

__device__ __forceinline__ void prologue(const Params& P, ldsp lds, int tid, int wave, int lane, int vcu, int G) {
    unsigned char* ws = P.ws;
    bf16* Wb = (bf16*)(ws + WS_W);
    LAS float* scr = (LAS float*)(lds + wave * 16384);
    const int gw = vcu * NWAVES + wave, NGW = G * NWAVES;
    constexpr int I_FFN = 8 * 2048, I_EVEN1 = 1280 + 512 + 32, I_ODD1 = 1536 + 512, NITEMS = I_FFN + 2 * I_EVEN1 + 2 * I_ODD1;
    for (int it = gw; it < NITEMS; it += NGW) {
        int r = it;
        if (r < I_FFN) { const int mat = r >> 11, L = mat >> 1; r &= 2047;
            if ((mat & 1) == 0) transpose_item(P.w_ffn_in + (size_t)L * DM * FF, DM, FF, FF, P.ffn_norm + L * DM, Wb + (W_FFN + (size_t)L * 16 * MiB) / 2, scr, r, lane);
            else transpose_item(P.w_ffn_out + (size_t)L * FF * DM, FF, DM, DM, nullptr, Wb + (W_FFN + (size_t)L * 16 * MiB + 8 * MiB) / 2, scr, r, lane);
            continue; }
        r -= I_FFN;
        if (r < 2 * I_EVEN1) { const int i = r / I_EVEN1; r -= i * I_EVEN1; bf16* base = Wb + (W_EVEN + (size_t)i * 8 * MiB) / 2;
            if (r < 1280) { transpose_item(P.ab_w_in + (size_t)i * DM * ABW, DM, ABW, ABW, P.mix_norm + (2 * i) * DM, base, scr, r, lane); continue; }
            r -= 1280;
            if (r < 512) { transpose_item(P.ab_w_out + (size_t)i * DM * DM, DM, DM, DM, nullptr, base + (5 * MiB) / 2, scr, r, lane); continue; }
            r -= 512;
            { const int gi = r >> 3; r &= 7; transpose_item(P.ab_w_pool + ((size_t)i * 4 + gi) * 128 * 128, 128, 128, 128, nullptr, base + (7 * MiB) / 2 + gi * 128 * 128, scr, r, lane); }
            continue; }
        r -= 2 * I_EVEN1;
        { const int i = r / I_ODD1; r -= i * I_ODD1; bf16* base = Wb + (W_ODD + (size_t)i * 8 * MiB) / 2;
            if (r < 1536) transpose_item(P.c_w_qkv + (size_t)i * DM * QKVW, DM, QKVW, QKVW, P.mix_norm + (2 * i + 1) * DM, base, scr, r, lane);
            else transpose_item(P.c_w_out + (size_t)i * DM * DM, DM, DM, DM, nullptr, base + (6 * MiB) / 2, scr, r - 1536, lane); }
    }
    float* ssq = (float*)(ws + WS_SSQ);
    bf16* XB = (bf16*)(ws + WS_XB);
    for (int m0 = gw * 4; m0 < MTOK; m0 += NGW * 4) {
        f32x4 v[4][4];
#pragma unroll
        for (int r = 0; r < 4; ++r) { const f32x4* xr = (const f32x4*)(P.x + (size_t)(m0 + r) * DM) + lane;
#pragma unroll
            for (int j = 0; j < 4; ++j) v[r][j] = xr[64 * j]; }
#pragma unroll
        for (int r = 0; r < 4; ++r) { float s = 0.f;
#pragma unroll
            for (int j = 0; j < 4; ++j) { const f32x4 t = v[r][j]; s += (t[0] * t[0] + t[1] * t[1]) + (t[2] * t[2] + t[3] * t[3]); u32x2 w; w.x = pk2(t[0], t[1]); w.y = pk2(t[2], t[3]); *(u32x2*)(XB + xb_off(m0 + r, 4 * lane + 256 * j)) = w; }
            s = wave_sum(s);
            if (lane < 16) ssq[(size_t)(m0 + r) * 16 + lane] = (lane == 0) ? s : 0.f; }
    }
    const int gt = vcu * NTHR + tid, NGT = G * NTHR;
    float* rot = (float*)(ws + WS_ROT);
    for (int i = gt; i < SEQ * 64; i += NGT) {
        const int pos = i >> 6, fi = i & 63;
        const float invf = (float)exp2(-(double)fi * (13.287712379549449 / 63.0));
        const float ang = (float)pos * invf;
        const double rev = (double)ang * 0.15915494309189535;
        const double fr = rev - floor(rev);
        const float a = (float)(fr * 6.283185307179586);
        rot[2 * i] = __cosf(a); rot[2 * i + 1] = __sinf(a);
    }
}

#define RET_KV_UPDATE(Kd_, Vs_) do { _Pragma("unroll") for (int ks = 0; ks < 2; ++ks) { \
        const int rowoff = (ks * 32 + g * 8 + (i >> 2)) * PITCH + 8 * (i & 3); \
        const bf16x8 Bv = trfrag((Vs_) + rowoff + wave * 32, 4 * PITCH); \
        _Pragma("unroll") for (int dt = 0; dt < 8; ++dt) { const bf16x8 Ak = trfrag((Kd_) + rowoff + dt * 32, 4 * PITCH); st[dt] = MFMA16(Ak, Bv, st[dt]); } } } while (0)
__device__ __forceinline__ void retA_phase(ldsp lds, const bf16* z, float* TS, int vcu, int G, int tid, int wave, int lane) {
    ldsp Kd = lds, Vs = lds + 64 * PITCH;
    const int i = lane & 15, g = lane >> 4, lr = tid >> 4, lc = tid & 15;
    u32x4 kreg[2], vreg[2];
    for (int unit = vcu; unit < 256; unit += G) {
        const int bh = unit >> 3, seg = unit & 7, h = bh & 3;
        const float lg = head_lg(h), cd = EX2(64.0f * lg);
        const int zrow = (bh >> 2) * SEQ + seg * 1024 + lr;
#define RA_LOAD(cc) do { _Pragma("unroll") for (int it = 0; it < 2; ++it) { const int rw_ = zrow + (cc) * 64 + it * 32; kreg[it] = *(const u32x4*)(z + z_off(rw_, 512 + h * 128 + lc * 8)); vreg[it] = *(const u32x4*)(z + z_off(rw_, 1024 + h * 128 + lc * 8)); } } while (0)
        RA_LOAD(0);
        f32x4 st[8];
#pragma unroll
        for (int dt = 0; dt < 8; ++dt) st[dt] = (f32x4){0.f, 0.f, 0.f, 0.f};
        for (int cc = 0; cc < 16; ++cc) {
#pragma unroll
            for (int it = 0; it < 2; ++it) {
                const int r = lr + it * 32; const float dk = EX2((float)(63 - r) * lg);
                u32x4 kk = kreg[it];
                kk.x = pk2(bflo(kk.x) * dk, bfhi(kk.x) * dk); kk.y = pk2(bflo(kk.y) * dk, bfhi(kk.y) * dk); kk.z = pk2(bflo(kk.z) * dk, bfhi(kk.z) * dk); kk.w = pk2(bflo(kk.w) * dk, bfhi(kk.w) * dk);
                *(LAS u32x4*)(Kd + r * PITCH + lc * 16) = kk; *(LAS u32x4*)(Vs + r * PITCH + lc * 16) = vreg[it];
            }
            __syncthreads();
            RA_LOAD(cc < 15 ? cc + 1 : cc);
#pragma unroll
            for (int dt = 0; dt < 8; ++dt) st[dt] = st[dt] * cd;
            RET_KV_UPDATE(Kd, Vs);
            __syncthreads();
        }
#undef RA_LOAD
        float* dst = TS + ((size_t)unit * 128 + wave * 16 + i) * 128 + g * 4;
#pragma unroll
        for (int dt = 0; dt < 8; ++dt) *(f32x4*)(dst + dt * 16) = st[dt];
    }
}

__device__ __forceinline__ void pool_phase(ldsp lds, const bf16* z, const bf16* WpT, const float* scale, bf16* CAT, int vcu, int G, int tid, int wave, int lane) {
    ldsp Ps = lds, PO = lds + 80 * PITCH;
    const int i = lane & 15, g = lane >> 4;
    const int gi = vcu & 3, wdw = 2 << gi;
    bf16x8 af[4];
#pragma unroll
    for (int ks = 0; ks < 4; ++ks) af[ks] = *(const bf16x8*)(WpT + (size_t)(gi * 128 + wave * 16 + i) * 128 + ks * 32 + g * 8);
    const f32x4 sc = *(const f32x4*)(scale + gi * 128 + wave * 16 + g * 4);
    u32x4 preg[3];
    const int nbc = BATCH * NCH;
#define POOL_LOAD(bc) do { const int c_ = (bc) & 127, b_ = (bc) >> 7; \
        _Pragma("unroll") for (int it = 0; it < 3; ++it) { const int ch = tid + it * 512, r = ch >> 4, cc = ch & 15, tok = c_ * 64 - 16 + r; preg[it] = (u32x4){0u, 0u, 0u, 0u}; \
            if (ch < 1280 && tok >= 0) preg[it] = *(const u32x4*)(z + z_off(b_ * SEQ + tok, 2048 + gi * 128 + cc * 8)); } } while (0)
    int bc = vcu >> 2; const int step = G >> 2;
    if (bc < nbc) POOL_LOAD(bc);
    for (; bc < nbc; bc += step) {
        const int c = bc & 127, b = bc >> 7;
        const size_t row0 = (size_t)b * SEQ + c * 64;
#pragma unroll
        for (int it = 0; it < 3; ++it) { const int ch = tid + it * 512; if (ch < 1280) *(LAS u32x4*)(Ps + (ch >> 4) * PITCH + (ch & 15) * 16) = preg[it]; }
        __syncthreads();
        if (bc + step < nbc) POOL_LOAD(bc + step);
        {
            const int t = tid >> 3, cb = (tid & 7) * 32;
            float s[16];
#pragma unroll
            for (int e = 0; e < 16; ++e) s[e] = 0.f;
            for (int jj = 0; jj < wdw; ++jj) {
                const ldsp p = Ps + (16 + t - jj) * PITCH + cb;
                const u32x4 a = *(const LAS u32x4*)p, b2 = *(const LAS u32x4*)(p + 16);
                s[0] += bflo(a.x); s[1] += bfhi(a.x); s[2] += bflo(a.y); s[3] += bfhi(a.y); s[4] += bflo(a.z); s[5] += bfhi(a.z); s[6] += bflo(a.w); s[7] += bfhi(a.w);
                s[8] += bflo(b2.x); s[9] += bfhi(b2.x); s[10] += bflo(b2.y); s[11] += bfhi(b2.y); s[12] += bflo(b2.z); s[13] += bfhi(b2.z); s[14] += bflo(b2.w); s[15] += bfhi(b2.w);
            }
            const int cnt = min(c * 64 + t + 1, wdw); const float inv = 1.0f / (float)cnt;
            const ldsp p0 = Ps + (16 + t) * PITCH + cb;
            const u32x4 a = *(const LAS u32x4*)p0, b2 = *(const LAS u32x4*)(p0 + 16);
            u32x4 o0, o1;
            o0.x = pk2(s[0] * inv - bflo(a.x), s[1] * inv - bfhi(a.x)); o0.y = pk2(s[2] * inv - bflo(a.y), s[3] * inv - bfhi(a.y));
            o0.z = pk2(s[4] * inv - bflo(a.z), s[5] * inv - bfhi(a.z)); o0.w = pk2(s[6] * inv - bflo(a.w), s[7] * inv - bfhi(a.w));
            o1.x = pk2(s[8] * inv - bflo(b2.x), s[9] * inv - bfhi(b2.x)); o1.y = pk2(s[10] * inv - bflo(b2.y), s[11] * inv - bfhi(b2.y));
            o1.z = pk2(s[12] * inv - bflo(b2.z), s[13] * inv - bfhi(b2.z)); o1.w = pk2(s[14] * inv - bflo(b2.w), s[15] * inv - bfhi(b2.w));
            *(LAS u32x4*)(PO + t * PITCH + cb) = o0; *(LAS u32x4*)(PO + t * PITCH + cb + 16) = o1;
        }
        __syncthreads();
#pragma unroll
        for (int tt = 0; tt < 4; ++tt) {
            f32x4 acc = (f32x4){0.f, 0.f, 0.f, 0.f};
#pragma unroll
            for (int ks = 0; ks < 4; ++ks) { const bf16x8 bfr = lds_rd16(PO + (tt * 16 + i) * PITCH + (ks * 32 + g * 8) * 2); acc = MFMA16(af[ks], bfr, acc); }
            acc = acc * sc;
            u32x2 w; w.x = pk2(acc[0], acc[1]); w.y = pk2(acc[2], acc[3]);
            *(u32x2*)(CAT + (row0 + tt * 16 + i) * DM + 512 + gi * 128 + wave * 16 + g * 4) = w;
        }
        __syncthreads();
    }
#undef POOL_LOAD
}

__device__ __forceinline__ void retA_pool_phase(ldsp lds, const bf16* z, float* TS, const bf16* WpT, const float* scale, bf16* CAT, int vcu, int tid, int wave, int lane) {
    ldsp Kd = lds, Vs = lds + 64 * PITCH, Ps = lds + 128 * PITCH, PO = lds + 208 * PITCH;
    const int i = lane & 15, g = lane >> 4, lr = tid >> 4, lc = tid & 15;
    const int unit = vcu, bh = unit >> 3, seg = unit & 7, h = bh & 3;
    const float lg = head_lg(h), cd = EX2(64.0f * lg);
    const int zrow = (bh >> 2) * SEQ + seg * 1024 + lr;
    u32x4 kreg[2], vreg[2];
#define RA_LOAD(cc) do { _Pragma("unroll") for (int it = 0; it < 2; ++it) { const int rw_ = zrow + (cc) * 64 + it * 32; kreg[it] = *(const u32x4*)(z + z_off(rw_, 512 + h * 128 + lc * 8)); vreg[it] = *(const u32x4*)(z + z_off(rw_, 1024 + h * 128 + lc * 8)); } } while (0)
    const int gi = vcu & 3, wdw = 2 << gi;
    bf16x8 af[4];
#pragma unroll
    for (int ks = 0; ks < 4; ++ks) af[ks] = *(const bf16x8*)(WpT + (size_t)(gi * 128 + wave * 16 + i) * 128 + ks * 32 + g * 8);
    const f32x4 sc = *(const f32x4*)(scale + gi * 128 + wave * 16 + g * 4);
    u32x4 preg[3];
#define POOL_LOAD(bc) do { const int c_ = (bc) & 127, b_ = (bc) >> 7; \
        _Pragma("unroll") for (int it = 0; it < 3; ++it) { const int ch = tid + it * 512, r = ch >> 4, cc = ch & 15, tok = c_ * 64 - 16 + r; preg[it] = (u32x4){0u, 0u, 0u, 0u}; \
            if (ch < 1280 && tok >= 0) preg[it] = *(const u32x4*)(z + z_off(b_ * SEQ + tok, 2048 + gi * 128 + cc * 8)); } } while (0)
    RA_LOAD(0); POOL_LOAD(vcu >> 2);
    f32x4 st[8];
#pragma unroll
    for (int dt = 0; dt < 8; ++dt) st[dt] = (f32x4){0.f, 0.f, 0.f, 0.f};
    for (int k = 0; k < 16; ++k) {
        const int bc = (vcu >> 2) + 64 * k, c = bc & 127, b = bc >> 7;
        const size_t row0 = (size_t)b * SEQ + c * 64;
#pragma unroll
        for (int it = 0; it < 2; ++it) {
            const int r = lr + it * 32; const float dk = EX2((float)(63 - r) * lg);
            u32x4 kk = kreg[it];
            kk.x = pk2(bflo(kk.x) * dk, bfhi(kk.x) * dk); kk.y = pk2(bflo(kk.y) * dk, bfhi(kk.y) * dk); kk.z = pk2(bflo(kk.z) * dk, bfhi(kk.z) * dk); kk.w = pk2(bflo(kk.w) * dk, bfhi(kk.w) * dk);
            *(LAS u32x4*)(Kd + r * PITCH + lc * 16) = kk; *(LAS u32x4*)(Vs + r * PITCH + lc * 16) = vreg[it];
        }
#pragma unroll
        for (int it = 0; it < 3; ++it) { const int ch = tid + it * 512; if (ch < 1280) *(LAS u32x4*)(Ps + (ch >> 4) * PITCH + (ch & 15) * 16) = preg[it]; }
        __syncthreads();
        { const int kn = (k < 15) ? k + 1 : k; RA_LOAD(kn); POOL_LOAD((vcu >> 2) + 64 * kn); }
#pragma unroll
        for (int dt = 0; dt < 8; ++dt) st[dt] = st[dt] * cd;
        RET_KV_UPDATE(Kd, Vs);
        {
            const int t = tid >> 3, cb = (tid & 7) * 32;
            float s[16];
#pragma unroll
            for (int e = 0; e < 16; ++e) s[e] = 0.f;
            for (int jj = 0; jj < wdw; ++jj) {
                const ldsp p = Ps + (16 + t - jj) * PITCH + cb;
                const u32x4 a = *(const LAS u32x4*)p, b2 = *(const LAS u32x4*)(p + 16);
                s[0] += bflo(a.x); s[1] += bfhi(a.x); s[2] += bflo(a.y); s[3] += bfhi(a.y); s[4] += bflo(a.z); s[5] += bfhi(a.z); s[6] += bflo(a.w); s[7] += bfhi(a.w);
                s[8] += bflo(b2.x); s[9] += bfhi(b2.x); s[10] += bflo(b2.y); s[11] += bfhi(b2.y); s[12] += bflo(b2.z); s[13] += bfhi(b2.z); s[14] += bflo(b2.w); s[15] += bfhi(b2.w);
            }
            const int cnt = min(c * 64 + t + 1, wdw); const float inv = 1.0f / (float)cnt;
            const ldsp p0 = Ps + (16 + t) * PITCH + cb;
            const u32x4 a = *(const LAS u32x4*)p0, b2 = *(const LAS u32x4*)(p0 + 16);
            u32x4 o0, o1;
            o0.x = pk2(s[0] * inv - bflo(a.x), s[1] * inv - bfhi(a.x)); o0.y = pk2(s[2] * inv - bflo(a.y), s[3] * inv - bfhi(a.y));
            o0.z = pk2(s[4] * inv - bflo(a.z), s[5] * inv - bfhi(a.z)); o0.w = pk2(s[6] * inv - bflo(a.w), s[7] * inv - bfhi(a.w));
            o1.x = pk2(s[8] * inv - bflo(b2.x), s[9] * inv - bfhi(b2.x)); o1.y = pk2(s[10] * inv - bflo(b2.y), s[11] * inv - bfhi(b2.y));
            o1.z = pk2(s[12] * inv - bflo(b2.z), s[13] * inv - bfhi(b2.z)); o1.w = pk2(s[14] * inv - bflo(b2.w), s[15] * inv - bfhi(b2.w));
            *(LAS u32x4*)(PO + t * PITCH + cb) = o0; *(LAS u32x4*)(PO + t * PITCH + cb + 16) = o1;
        }
        __syncthreads();
#pragma unroll
        for (int tt = 0; tt < 4; ++tt) {
            f32x4 acc = (f32x4){0.f, 0.f, 0.f, 0.f};
#pragma unroll
            for (int ks = 0; ks < 4; ++ks) { const bf16x8 bfr = lds_rd16(PO + (tt * 16 + i) * PITCH + (ks * 32 + g * 8) * 2); acc = MFMA16(af[ks], bfr, acc); }
            acc = acc * sc;
            u32x2 w; w.x = pk2(acc[0], acc[1]); w.y = pk2(acc[2], acc[3]);
            *(u32x2*)(CAT + (row0 + tt * 16 + i) * DM + 512 + gi * 128 + wave * 16 + g * 4) = w;
        }
    }
    __syncthreads();
#undef RA_LOAD
#undef POOL_LOAD
    float* dst = TS + ((size_t)unit * 128 + wave * 16 + i) * 128 + g * 4;
#pragma unroll
    for (int dt = 0; dt < 8; ++dt) *(f32x4*)(dst + dt * 16) = st[dt];
}

__device__ __forceinline__ void retB_phase(ldsp lds, const bf16* z, const float* TS, const float* gn_gain, bf16* CAT, int vcu, int G, int tid, int wave, int lane) {
    ldsp Qs = lds, Ks = lds + 64 * PITCH, Vs = lds + 128 * PITCH, Kd = lds + 256 * PITCH, STs = lds + 320 * PITCH;
    const int i = lane & 15, g = lane >> 4, nt = wave & 3, eh = wave >> 2, lr = tid >> 4, lc = tid & 15;
    u32x4 qreg[2], kreg[2], vreg[2], greg[2];
    for (int unit = vcu; unit < 256; unit += G) {
        const int bh = unit >> 3, seg = unit & 7, b = bh >> 2, h = bh & 3;
        f32x4 gg[4];
#pragma unroll
        for (int et = 0; et < 4; ++et) gg[et] = *(const f32x4*)(gn_gain + h * 128 + eh * 64 + et * 16 + g * 4);
        const float lg = head_lg(h), cd = EX2(64.0f * lg);
        const int zrow = b * SEQ + seg * 1024 + lr;
#define RB_LOAD(cc) do { _Pragma("unroll") for (int it = 0; it < 2; ++it) { const int rw_ = zrow + (cc) * 64 + it * 32, cl_ = h * 128 + lc * 8; \
            qreg[it] = *(const u32x4*)(z + z_off(rw_, cl_)); kreg[it] = *(const u32x4*)(z + z_off(rw_, 512 + cl_)); vreg[it] = *(const u32x4*)(z + z_off(rw_, 1024 + cl_)); greg[it] = *(const u32x4*)(z + z_off(rw_, 1536 + cl_)); } } while (0)
        RB_LOAD(0);
        f32x4 st[8];
#pragma unroll
        for (int dt = 0; dt < 8; ++dt) st[dt] = (f32x4){0.f, 0.f, 0.f, 0.f};
        for (int sp = 0; sp < seg; ++sp) {
            const float wsp = EX2(1024.0f * lg * (float)(seg - 1 - sp));
            const float* src = TS + ((size_t)(bh * 8 + sp) * 128 + wave * 16 + i) * 128 + g * 4;
#pragma unroll
            for (int dt = 0; dt < 8; ++dt) st[dt] = st[dt] + *(const f32x4*)(src + dt * 16) * wsp;
        }
        for (int cc = 0; cc < 16; ++cc) {
            const size_t row0 = (size_t)b * SEQ + (size_t)(seg * 16 + cc) * 64;
            const ldsp Gs = (cc & 1) ? lds + 448 * PITCH : lds + 192 * PITCH;
            LAS float* RED = (LAS float*)(lds + 512 * PITCH) + (cc & 1) * 256;
#pragma unroll
            for (int it = 0; it < 2; ++it) { const int r = lr + it * 32, off = r * PITCH + lc * 16; const float dk = EX2((float)(63 - r) * lg);
                u32x4 kk = kreg[it];
                kk.x = pk2(bflo(kk.x) * dk, bfhi(kk.x) * dk); kk.y = pk2(bflo(kk.y) * dk, bfhi(kk.y) * dk); kk.z = pk2(bflo(kk.z) * dk, bfhi(kk.z) * dk); kk.w = pk2(bflo(kk.w) * dk, bfhi(kk.w) * dk);
                *(LAS u32x4*)(Qs + off) = qreg[it]; *(LAS u32x4*)(Ks + off) = kreg[it]; *(LAS u32x4*)(Vs + off) = vreg[it]; *(LAS u32x4*)(Gs + off) = greg[it]; *(LAS u32x4*)(Kd + off) = kk; }
#pragma unroll
            for (int dt = 0; dt < 8; ++dt) { u32x2 w; w.x = pk2(st[dt][0], st[dt][1]); w.y = pk2(st[dt][2], st[dt][3]); *(LAS u32x2*)(STs + (wave * 16 + i) * PITCH + (dt * 16 + g * 4) * 2) = w; }
            __syncthreads();
            RB_LOAD(cc < 15 ? cc + 1 : cc);
            bf16x8 qf[4];
#pragma unroll
            for (int ks = 0; ks < 4; ++ks) qf[ks] = lds_rd16(Qs + (nt * 16 + i) * PITCH + (ks * 32 + g * 8) * 2);
            f32x4 sT[4];
#pragma unroll
            for (int mt = 0; mt < 4; ++mt) { sT[mt] = (f32x4){0.f, 0.f, 0.f, 0.f};
#pragma unroll
                for (int ks = 0; ks < 4; ++ks) { const bf16x8 kf = lds_rd16(Ks + (mt * 16 + i) * PITCH + (ks * 32 + g * 8) * 2); sT[mt] = MFMA16(kf, qf[ks], sT[mt]); } }
            const int n = nt * 16 + i;
#pragma unroll
            for (int mt = 0; mt < 4; ++mt)
#pragma unroll
                for (int j = 0; j < 4; ++j) { const int m = mt * 16 + g * 4 + j; sT[mt][j] *= EX2(fabsf((float)(n - m)) * lg); }
            bf16x8 Pf[2]; Pf[0] = pack8(sT[0], sT[1]); Pf[1] = pack8(sT[2], sT[3]);
            f32x4 o[4];
            const float qd = EX2((float)(n + 1) * lg);
#pragma unroll
            for (int et = 0; et < 4; ++et) { o[et] = (f32x4){0.f, 0.f, 0.f, 0.f}; const int e0 = (eh * 4 + et) * 16;
#pragma unroll
                for (int ks = 0; ks < 4; ++ks) { const bf16x8 sf = lds_rd16(STs + (e0 + i) * PITCH + (ks * 32 + g * 8) * 2); o[et] = MFMA16(sf, qf[ks], o[et]); }
                o[et] = o[et] * qd; }
#pragma unroll
            for (int ks2 = 0; ks2 < 2; ++ks2)
#pragma unroll
                for (int et = 0; et < 4; ++et) { const int e0 = (eh * 4 + et) * 16;
                    const bf16x8 vf = trfrag(Vs + (ks2 * 32 + g * 4 + (i >> 2)) * PITCH + (e0 + 4 * (i & 3)) * 2, 16 * PITCH); o[et] = MFMA16(vf, Pf[ks2], o[et]); }
#pragma unroll
            for (int dt = 0; dt < 8; ++dt) st[dt] = st[dt] * cd;
            RET_KV_UPDATE(Kd, Vs);
            float a1 = 0.f, a2 = 0.f;
#pragma unroll
            for (int et = 0; et < 4; ++et)
#pragma unroll
                for (int j = 0; j < 4; ++j) { a1 += o[et][j]; a2 += o[et][j] * o[et][j]; }
            a1 = xrow_sum(a1); a2 = xrow_sum(a2);
            if (g == 0) { RED[(wave * 16 + i) * 2] = a1; RED[(wave * 16 + i) * 2 + 1] = a2; }
            __syncthreads();
            {
                const float pa = RED[((wave ^ 4) * 16 + i) * 2], pq = RED[((wave ^ 4) * 16 + i) * 2 + 1];
                const float mean = (a1 + pa) * (1.0f / 128.0f), var = fmaxf((a2 + pq) * (1.0f / 128.0f) - mean * mean, 0.f), rstd = rsqrtf(var + GN_EPS);
                const size_t row = row0 + n;
#pragma unroll
                for (int et = 0; et < 4; ++et) { const int e = eh * 64 + et * 16 + g * 4;
                    const u32x2 gw = *(const LAS u32x2*)(Gs + n * PITCH + e * 2);
                    const float g0 = bflo(gw.x), g1 = bfhi(gw.x), g2 = bflo(gw.y), g3 = bfhi(gw.y);
                    const float y0 = (o[et][0] - mean) * rstd * gg[et][0] * (g0 / (1.0f + __expf(-g0)));
                    const float y1 = (o[et][1] - mean) * rstd * gg[et][1] * (g1 / (1.0f + __expf(-g1)));
                    const float y2 = (o[et][2] - mean) * rstd * gg[et][2] * (g2 / (1.0f + __expf(-g2)));
                    const float y3 = (o[et][3] - mean) * rstd * gg[et][3] * (g3 / (1.0f + __expf(-g3)));
                    u32x2 w; w.x = pk2(y0, y1); w.y = pk2(y2, y3);
                    *(u32x2*)(CAT + row * DM + h * 128 + e) = w; }
            }
        }
        __syncthreads();
#undef RB_LOAD
    }
}

constexpr int KPITCH = 144, VPITCH = 160;
constexpr int ATT_BUF = 64 * KPITCH + 64 * VPITCH;
__device__ __forceinline__ void attn_phase(ldsp lds, const bf16* qkv, const float* relb, bf16* O, int vcu, int G, int tid, int wave, int lane) {
    const int head = vcu & 15;
    LAS float* BH = (LAS float*)(lds + 4 * ATT_BUF);
    for (int t2 = tid; t2 < 257; t2 += NTHR) BH[t2] = relb[head * 257 + t2] * LOG2E;
    const int i = lane & 15, g = lane >> 4, cw = wave >> 1, qh = wave & 1;
    const int lr = tid >> 3, lc = tid & 7;
    u32x4 kA, vA, kB, vB;
#define ATT_B(u_) (((u_) & 255) >> 5)
#define ATT_C0(u_) ((((u_) >> 8) * 2 + ((((u_) & 255) >> 4) & 1)) * 4)
#define ATT_T0(c0_) (((c0_) < 8) ? 0 : (c0_) - 8)
#define ATT_LOAD(KR, VR) do { const size_t rw_ = (size_t)ATT_B(ul) * SEQ + (size_t)Tl * 64 + lr;     \
        const bf16* src = qkv + ((rw_ >> 4) * (QKVW >> 5) + 32 + head * 2 + (lc >> 2)) * 512 + (rw_ & 15) * 32 + (lc & 3) * 8; KR = *(const u32x4*)src; VR = *(const u32x4*)(src + 32 * 512); \
        if (Tl == ATT_C0(ul) + 3) { if (ul + G < 4096) { ul += G; Tl = ATT_T0(ATT_C0(ul)); } } else ++Tl; } while (0)
#define ATT_QLOAD(dst, b_, c_) do { const size_t qr_ = (size_t)(b_) * SEQ + (c_) * 64 + qh * 32 + i; \
        _Pragma("unroll") for (int qa = 0; qa < 2; ++qa) _Pragma("unroll") for (int ks = 0; ks < 2; ++ks) dst[qa][ks] = *(const bf16x8*)(qkv + (((qr_ + qa * 16) >> 4) * (QKVW >> 5) + head * 2 + ks) * 512 + ((qr_ + qa * 16) & 15) * 32 + g * 8); } while (0)
    int u = vcu, par = 0;
    int ul = vcu, Tl = ATT_T0(ATT_C0(vcu));
    bf16x8 qf[2][2], qn[2][2];
    ATT_LOAD(kA, vA); ATT_LOAD(kB, vB);
    if (u < 4096) ATT_QLOAD(qf, ATT_B(u), ATT_C0(u) + cw);
    for (; u < 4096; u += G) {
        const int b = ATT_B(u), c0 = ATT_C0(u);
        const int c = c0 + cw;
        const int T0 = ATT_T0(c0), T1 = c0 + 3;
        const bool has_next = (u + G < 4096);
        float m_i[2] = {0.f, 0.f}, l_i[2] = {0.f, 0.f};
        const int tfirst = (c < 8) ? 8 - c : 0;
        f32x4 acc[2][4];
#pragma unroll
        for (int qa = 0; qa < 2; ++qa)
#pragma unroll
            for (int dt = 0; dt < 4; ++dt) acc[qa][dt] = (f32x4){0.f, 0.f, 0.f, 0.f};
#define ATT_STEP(Kt, T) do { \
            const ldsp Vt = (Kt) + 64 * KPITCH; \
            const int t = (T) - (c - 8);                            \
            if (t >= 0 && t <= 8) { \
                const float cb = (t <= 5) ? BH[256] : 0.f;          \
                f32x4 sT[2][4]; \
                const float i0 = cb - m_i[0], i1 = cb - m_i[1]; \
                _Pragma("unroll") for (int kt = 0; kt < 4; ++kt) { sT[0][kt] = (f32x4){i0, i0, i0, i0}; sT[1][kt] = (f32x4){i1, i1, i1, i1}; \
                    _Pragma("unroll") for (int ks = 0; ks < 2; ++ks) { const bf16x8 kf = lds_rd16(Kt + (kt * 16 + i) * KPITCH + (ks * 32 + g * 8) * 2); \
                        sT[0][kt] = MFMA16(kf, qf[0][ks], sT[0][kt]); sT[1][kt] = MFMA16(kf, qf[1][ks], sT[1][kt]); } } \
                if (t > 5) { \
                    _Pragma("unroll") for (int qa = 0; qa < 2; ++qa) { const int base = (qh * 32 + qa * 16 + i) + 640 - t * 64 - g * 4; \
                        _Pragma("unroll") for (int kt = 0; kt < 4; ++kt) \
                            _Pragma("unroll") for (int j = 0; j < 4; ++j) sT[qa][kt][j] += BH[min(base - kt * 16 - j, 256)]; } \
                } \
                bf16x8 Pb[2][2]; \
                _Pragma("unroll") for (int qa = 0; qa < 2; ++qa) { \
                    float mx = fmaxf(fmaxf(sT[qa][0][0], sT[qa][0][1]), fmaxf(sT[qa][0][2], sT[qa][0][3])); \
                    _Pragma("unroll") for (int kt = 1; kt < 4; ++kt) mx = fmaxf(mx, fmaxf(fmaxf(sT[qa][kt][0], sT[qa][kt][1]), fmaxf(sT[qa][kt][2], sT[qa][kt][3]))); \
                    mx = xrow_max(mx);                              \
                    if (t == tfirst || __any(mx > 8.0f)) {          \
                        const float dl = (t == tfirst) ? mx : fmaxf(mx, 0.f), alpha = (t == tfirst) ? 1.0f : EX2(-dl); m_i[qa] += dl;     \
                        _Pragma("unroll") for (int kt = 0; kt < 4; ++kt) sT[qa][kt] = sT[qa][kt] - dl; \
                        l_i[qa] *= alpha; \
                        _Pragma("unroll") for (int dt = 0; dt < 4; ++dt) acc[qa][dt] = acc[qa][dt] * alpha; \
                    } \
                    float rs = 0.f; \
                    _Pragma("unroll") for (int kt = 0; kt < 4; ++kt) \
                        _Pragma("unroll") for (int j = 0; j < 4; ++j) { const float p = EX2(sT[qa][kt][j]); sT[qa][kt][j] = p; rs += p; } \
                    l_i[qa] += rs; \
                    Pb[qa][0] = pack8(sT[qa][0], sT[qa][1]); Pb[qa][1] = pack8(sT[qa][2], sT[qa][3]); \
                } \
                _Pragma("unroll") for (int ks2 = 0; ks2 < 2; ++ks2) \
                    _Pragma("unroll") for (int dt = 0; dt < 4; ++dt) { const bf16x8 vf = trfrag(Vt + (ks2 * 32 + g * 4 + (i >> 2)) * VPITCH + (dt * 16 + 4 * (i & 3)) * 2, 16 * VPITCH); \
                        acc[0][dt] = MFMA16(vf, Pb[0][ks2], acc[0][dt]); acc[1][dt] = MFMA16(vf, Pb[1][ks2], acc[1][dt]); } \
            } } while (0)
        { const int un = has_next ? u + G : u; ATT_QLOAD(qn, ATT_B(un), ATT_C0(un) + cw); }
        for (int T = T0; T <= T1; T += 2) {
            const ldsp K0 = lds + (2 * par) * ATT_BUF, K1 = K0 + ATT_BUF; par ^= 1;
            *(LAS u32x4*)(K0 + lr * KPITCH + lc * 16) = kA; *(LAS u32x4*)(K0 + 64 * KPITCH + lr * VPITCH + lc * 16) = vA;
            *(LAS u32x4*)(K1 + lr * KPITCH + lc * 16) = kB; *(LAS u32x4*)(K1 + 64 * KPITCH + lr * VPITCH + lc * 16) = vB;
            __syncthreads();
            ATT_LOAD(kA, vA); ATT_LOAD(kB, vB);
            ATT_STEP(K0, T); ATT_STEP(K1, T + 1);
        }
#undef ATT_STEP
        const size_t qrow0 = (size_t)b * SEQ + c * 64 + qh * 32 + i;
#pragma unroll
        for (int qa = 0; qa < 2; ++qa) {
            const float inv = 1.0f / xrow_sum(l_i[qa]);
#pragma unroll
            for (int dt = 0; dt < 4; ++dt) { u32x2 w; w.x = pk2(acc[qa][dt][0] * inv, acc[qa][dt][1] * inv); w.y = pk2(acc[qa][dt][2] * inv, acc[qa][dt][3] * inv);
                *(u32x2*)(O + (qrow0 + qa * 16) * DM + head * 64 + dt * 16 + g * 4) = w; }
        }
#pragma unroll
        for (int qa = 0; qa < 2; ++qa)
#pragma unroll
            for (int ks = 0; ks < 2; ++ks) qf[qa][ks] = qn[qa][ks];
    }
    __syncthreads();
#undef ATT_LOAD
#undef ATT_QLOAD
#undef ATT_B
#undef ATT_C0
#undef ATT_T0
}

#define XB_TMO      128
#define XB_XCNT(j)  (256  + 64 * (j))
#define XB_XSUB(j)  (1280 + 64 * (j))
#define XB_XGEN(j)  (2304 + 64 * (j))
#define XB_TOP      3328
#define XB_TOPGEN   3392
#define XCD_BAR_WORDS 3456
#define XB_SPIN_CAP (1u << 18)

__device__ __forceinline__ unsigned xb_ld(unsigned* p)              { return __hip_atomic_load(p, __ATOMIC_RELAXED, __HIP_MEMORY_SCOPE_AGENT); }
__device__ __forceinline__ unsigned xb_add(unsigned* p, unsigned v) { return __hip_atomic_fetch_add(p, v, __ATOMIC_RELAXED, __HIP_MEMORY_SCOPE_AGENT); }
__device__ __forceinline__ unsigned xb_xcc_id() { return (unsigned)__builtin_amdgcn_s_getreg((3 << 11) | 20) & 0xFu; }
#define XB_SPIN(cond, bar) do { unsigned _sp = 0; while (cond) { __builtin_amdgcn_s_sleep(1); \
    if ((++_sp & 255u) == 0u) { if (xb_ld(&(bar)[XB_TMO])) break; if (_sp > XB_SPIN_CAP) { atomicAdd(&(bar)[XB_TMO], 1u); break; } } } } while (0)

struct XcdBarrier {
    unsigned* bar; unsigned x;
    volatile LAS unsigned* st;
};

__device__ __forceinline__ XcdBarrier xcd_barrier_post(unsigned* bar, volatile LAS unsigned* st) {
    XcdBarrier b; b.bar = bar; b.x = xb_xcc_id(); b.st = st;
    if (threadIdx.x == 0) (void)xb_add(&bar[XB_XCNT(b.x)], 1u);
    return b;
}
__device__ __forceinline__ void xcd_barrier_complete(unsigned* bar, unsigned x, unsigned& nloc, unsigned& nx) {
    const unsigned G = gridDim.x * gridDim.y * gridDim.z;
    unsigned sum, cnt, mine, sp = 0u;
    for (;;) {
        sum = 0u; cnt = 0u; mine = 0u;
#pragma unroll
        for (unsigned j = 0; j < 16; ++j) { const unsigned c = xb_ld(&bar[XB_XCNT(j)]); sum += c; cnt += (c > 0u) ? 1u : 0u; mine = (j == x) ? c : mine; }
        if (sum == G) break;
        __builtin_amdgcn_s_sleep(1);
        if ((++sp & 255u) == 0u) { if (xb_ld(&bar[XB_TMO])) break; if (sp > XB_SPIN_CAP) { atomicAdd(&bar[XB_TMO], 1u); break; } }
    }
    nloc = mine > 0u ? mine : 1u; nx = cnt > 0u ? cnt : 1u;
}

__device__ __forceinline__ void xcd_barrier(const XcdBarrier& b) {
    asm volatile("s_waitcnt vmcnt(0)" ::: "memory");
    __syncthreads();
    if (threadIdx.x == 0) {
        unsigned* bar = b.bar;
        __builtin_amdgcn_s_waitcnt(0);
        unsigned nloc = b.st[0], nx = b.st[1];
        if (nloc == 0u) { xcd_barrier_complete(bar, b.x, nloc, nx); b.st[0] = nloc; b.st[1] = nx; }
        const unsigned old = xb_add(&bar[XB_XSUB(b.x)], 1u);
        const unsigned gen = old / nloc;
        if (old + 1u == (gen + 1u) * nloc) {
            __builtin_amdgcn_fence(__ATOMIC_RELEASE, "agent");
            asm volatile("s_waitcnt vmcnt(0)" ::: "memory");
            const unsigned og = xb_add(&bar[XB_TOP], 1u);
            const unsigned tg = og / nx;
            if (og + 1u == (tg + 1u) * nx) xb_add(&bar[XB_TOPGEN], 1u);
            else XB_SPIN(xb_ld(&bar[XB_TOPGEN]) == tg, bar);
            __builtin_amdgcn_fence(__ATOMIC_ACQUIRE, "agent");
            xb_add(&bar[XB_XGEN(b.x)], 1u);
            asm volatile("s_waitcnt vmcnt(0)" ::: "memory");
        } else {
            XB_SPIN(xb_ld(&bar[XB_XGEN(b.x)]) == gen, bar);
            __builtin_amdgcn_fence(__ATOMIC_ACQUIRE, "agent");
            asm volatile("s_waitcnt vmcnt(0)" ::: "memory");
        }
    }
    __syncthreads();
}

__global__ void __launch_bounds__(NTHR, 2) fwd_megakernel(Params P) {
    extern __shared__ __attribute__((aligned(16))) unsigned char lds_raw[];
    const ldsp lds = (ldsp)lds_raw;
    cg::grid_group grid = cg::this_grid();
    const int tid0 = threadIdx.x;
    const int G = gridDim.x, bx = blockIdx.x;
    const int vcu = (G % 8 == 0) ? (bx % 8) * (G / 8) + bx / 8 : bx;
    unsigned char* ws = P.ws;
    float* ssq = (float*)(ws + WS_SSQ);
    const float* rot = (const float*)(ws + WS_ROT);
    bf16* Wb = (bf16*)(ws + WS_W);
    bf16* XB = (bf16*)(ws + WS_XB);
    float* TS = (float*)(ws + WS_KV);
    bf16* BIG = (bf16*)(ws + WS_BIG);
    bf16* Z = BIG; bf16* CAT = BIG + (size_t)MTOK * ABW;
    bf16* QKV = BIG; bf16* OB = BIG + (size_t)MTOK * QKVW;
    bf16* HB = BIG;
    const int lo = P.ph_lo, hi = P.ph_hi;
    int ph = 0;
    volatile LAS unsigned* BST = (volatile LAS unsigned*)(lds + LDS_BYTES - 64);
    if (tid0 == 0) { BST[0] = 0u; BST[1] = 0u; }
    __syncthreads();
    unsigned* barw = (unsigned*)ws;
    XcdBarrier xbar; xbar.bar = barw; xbar.x = 0; xbar.st = BST;
#ifndef PH_MASK
#define PH_MASK 0xffff
#endif
#ifndef DUP_MASK
#define DUP_MASK 0
#endif
#define PHASE_BEGIN_K(k) if (((PH_MASK >> (k)) & 1) && ph >= lo && ph < hi) { for (int rep_ = 0; rep_ < (((DUP_MASK >> (k)) & 1) ? 2 : 1); ++rep_) { int tid = tid0; asm volatile("" : "+v"(tid)); const int lane = tid & 63, wave = __builtin_amdgcn_readfirstlane(tid >> 6); (void)lane; (void)wave;
#define PHASE_END   if (ph + 1 < hi) { if (ph == 0) { asm volatile("s_waitcnt vmcnt(0) lgkmcnt(0)" ::: "memory"); grid.sync(); __builtin_amdgcn_fence(__ATOMIC_ACQUIRE, "agent"); asm volatile("s_waitcnt vmcnt(0)" ::: "memory"); \
            xbar = xcd_barrier_post(barw, BST); } else xcd_barrier(xbar); } } } ++ph;

    PHASE_BEGIN_K(0) if (bx == 0) { for (int k_ = tid; k_ < 4096; k_ += NTHR) barw[k_] = 0u; } prologue(P, lds, tid, wave, lane, vcu, G); PHASE_END

    for (int L = 0; L < DEPTH; ++L) {
        const int li = L >> 1;
        if ((L & 1) == 0) {
            const bf16* Wint = Wb + (W_EVEN + (size_t)li * 8 * MiB) / 2; const bf16* Woutt = Wint + (5 * MiB) / 2; const bf16* WpT = Wint + (7 * MiB) / 2;
            PHASE_BEGIN_K(1)
                pg8::Gemm g{XB, Wint, MTOK, ABW, DM}; pg8::StaticOrder S; S.init(MTOK, ABW, G, bx);
                EpiProj<0> E{Z, ABW, ssq, rot};
                pg8::gemm_phase<EpiProj<0>, pg8::StaticOrder, true, true, true>(lds, g, S, E);
            PHASE_END
            PHASE_BEGIN_K(2)
                if (G == 256) retA_pool_phase(lds, Z, TS, WpT, P.ab_pool_scale + li * 512, CAT, vcu, tid, wave, lane);
                else { retA_phase(lds, Z, TS, vcu, G, tid, wave, lane); pool_phase(lds, Z, WpT, P.ab_pool_scale + li * 512, CAT, vcu, G, tid, wave, lane); }
            PHASE_END
            PHASE_BEGIN_K(4)
                retB_phase(lds, Z, TS, P.ab_gn_gain + li * 512, CAT, vcu, G, tid, wave, lane);
            PHASE_END
            PHASE_BEGIN_K(5)
                pg8::Gemm g{CAT, Woutt, MTOK, DM, DM}; pg8::StaticOrder S; S.init(MTOK, DM, G, bx);
                EpiRes E{(L == 0) ? P.x : (const float*)nullptr, (float*)nullptr, XB, ssq + (size_t)MTOK * 16, (const float*)nullptr};
                pg8::gemm_phase<EpiRes, pg8::StaticOrder, true, true>(lds, g, S, E);
            PHASE_END
        } else {
            const bf16* Wqkvt = Wb + (W_ODD + (size_t)li * 8 * MiB) / 2; const bf16* Wot = Wqkvt + (6 * MiB) / 2;
            PHASE_BEGIN_K(6)
                pg8::Gemm g{XB, Wqkvt, MTOK, QKVW, DM}; pg8::StaticOrder S; S.init(MTOK, QKVW, G, bx);
                EpiProj<2> E{QKV, QKVW, ssq, rot};
                pg8::gemm_phase<EpiProj<2>, pg8::StaticOrder, true, true, true>(lds, g, S, E);
            PHASE_END
            PHASE_BEGIN_K(7)
                attn_phase(lds, QKV, P.c_rel_bias + li * 16 * 257, OB, vcu, G, tid, wave, lane);
            PHASE_END
            PHASE_BEGIN_K(8)
                pg8::Gemm g{OB, Wot, MTOK, DM, DM}; pg8::StaticOrder S; S.init(MTOK, DM, G, bx);
                EpiRes E{(L == 0) ? P.x : (const float*)nullptr, (float*)nullptr, XB, ssq + (size_t)MTOK * 16, (const float*)nullptr};
                pg8::gemm_phase<EpiRes, pg8::StaticOrder, true, true>(lds, g, S, E);
            PHASE_END
        }
        const bf16* W1t = Wb + (W_FFN + (size_t)L * 16 * MiB) / 2; const bf16* W2t = W1t + (8 * MiB) / 2;
        PHASE_BEGIN_K(9)
            pg8::Gemm g{XB, W1t, MTOK, FF, DM}; pg8::StaticOrder S; S.init(MTOK, FF, G, bx);
            EpiProj<1> E{HB, FF, ssq + (size_t)MTOK * 16, rot};
            pg8::gemm_phase<EpiProj<1>, pg8::StaticOrder, true, true, true>(lds, g, S, E);
        PHASE_END
        PHASE_BEGIN_K(10)
            pg8::Gemm g{HB, W2t, MTOK, DM, FF}; pg8::StaticOrder S; S.init(MTOK, DM, G, bx);
            EpiRes E{(const float*)nullptr, (L == DEPTH - 1) ? P.out : (float*)nullptr, XB, ssq, ssq + (size_t)MTOK * 16};
            pg8::gemm_phase<EpiRes, pg8::StaticOrder, true, true, true>(lds, g, S, E);
        PHASE_END
    }
    PHASE_BEGIN_K(11)
        const int gw = vcu * NWAVES + wave, NGW = G * NWAVES;
        const f32x4* gr = (const f32x4*)P.final_norm + lane;
        f32x4 gv[4];
#pragma unroll
        for (int j = 0; j < 4; ++j) gv[j] = gr[64 * j];
        for (int m0 = gw * 4; m0 < MTOK; m0 += NGW * 4) {
            f32x4 v[4][4]; float rs[4];
#pragma unroll
            for (int r = 0; r < 4; ++r) { const f32x4* xr = (const f32x4*)(P.out + (size_t)(m0 + r) * DM) + lane; rs[r] = row_rstd(ssq, (size_t)(m0 + r));
#pragma unroll
                for (int j = 0; j < 4; ++j) v[r][j] = xr[64 * j]; }
#pragma unroll
            for (int r = 0; r < 4; ++r) { f32x4* xo = (f32x4*)(P.out + (size_t)(m0 + r) * DM) + lane;
#pragma unroll
                for (int j = 0; j < 4; ++j) xo[64 * j] = v[r][j] * rs[r] * gv[j]; }
        }
    PHASE_END
#undef PHASE_BEGIN_K
#undef PHASE_END
}

extern "C" void kernel_launch(void* const* d_in, const int* in_sizes, int n_in, void* d_out, int out_size, void* d_ws, size_t ws_size, hipStream_t stream) {
    static int grid = 0;
    if (grid == 0) {
        if (n_in != 14 || in_sizes[0] != MTOK * DM || out_size != MTOK * DM || ws_size < WS_END) {
            fprintf(stderr, "kernel_launch: unexpected shapes/workspace: n_in %d in0 %d out %d ws %zu (need %zu)\n", n_in, n_in > 0 ? in_sizes[0] : -1, out_size, ws_size, (size_t)WS_END); grid = -1; return; }
        int dev = 0, cus = 0, per_cu = 0;
        if (hipGetDevice(&dev) != hipSuccess || hipDeviceGetAttribute(&cus, hipDeviceAttributeMultiprocessorCount, dev) != hipSuccess) { grid = -1; return; }
        if (hipFuncSetAttribute((const void*)fwd_megakernel, hipFuncAttributeMaxDynamicSharedMemorySize, LDS_BYTES) != hipSuccess) { fprintf(stderr, "kernel_launch: hipFuncSetAttribute failed\n"); grid = -1; return; }
        if (hipOccupancyMaxActiveBlocksPerMultiprocessor(&per_cu, (const void*)fwd_megakernel, NTHR, LDS_BYTES) != hipSuccess || per_cu < 1) { fprintf(stderr, "kernel_launch: occupancy query says %d\n", per_cu); per_cu = 1; }
        (void)hipGetLastError();
        grid = cus;
    }
    if (grid < 0) return;
    Params p{};
    p.x = (const float*)d_in[0]; p.mix_norm = (const float*)d_in[1]; p.ffn_norm = (const float*)d_in[2]; p.w_ffn_in = (const float*)d_in[3]; p.w_ffn_out = (const float*)d_in[4];
    p.ab_w_in = (const float*)d_in[5]; p.ab_gn_gain = (const float*)d_in[6]; p.ab_w_pool = (const float*)d_in[7]; p.ab_pool_scale = (const float*)d_in[8]; p.ab_w_out = (const float*)d_in[9];
    p.c_w_qkv = (const float*)d_in[10]; p.c_rel_bias = (const float*)d_in[11]; p.c_w_out = (const float*)d_in[12]; p.final_norm = (const float*)d_in[13];
    p.out = (float*)d_out; p.ws = (unsigned char*)d_ws; p.ph_lo = 0; p.ph_hi = 1 << 20;
    void* args[] = {&p};
    const hipError_t e = hipLaunchCooperativeKernel((const void*)fwd_megakernel, dim3(grid), dim3(NTHR), args, LDS_BYTES, stream);
    if (e != hipSuccess) fprintf(stderr, "kernel_launch: cooperative launch failed: %s (grid %d)\n", hipGetErrorString(e), grid);
}
```
